# Optimizing an MI355X kernel written in HIP

```python
import jax
import jax.numpy as jnp
from jax import lax
import numpy as np

D_MODEL = 1024
BATCH = 4
SEQ = 4096
DEPTH = 2

GRID_W = 64
CTX_LEN = 256
NORM_EPS = 1e-6
ROPE_BASE = 10000.0
N_MOD = 6

MLA_HEADS = 8
MLA_Q_LORA = 384
MLA_KV_LORA = 256
MLA_NOPE = 64
MLA_ROPE = 32
MLA_V = 64
MLA_WIDTH = MLA_HEADS * MLA_V
MLA_SCALE = (MLA_NOPE + MLA_ROPE) ** -0.5
ATTN_Q_BLOCK = 128

POOL_WINDOWS = (2, 4, 8, 16)
POOL_GROUPS = 4
POOL_GROUP_DIM = 128
POOL_WIDTH = POOL_GROUPS * POOL_GROUP_DIM

SWA_Q_HEADS = 8
SWA_KV_HEADS = 2
SWA_HEAD_DIM = 64
SWA_WINDOW = 128
SWA_BLOCK = 128
SWA_WIDTH = SWA_Q_HEADS * SWA_HEAD_DIM
SWA_SCALE = SWA_HEAD_DIM ** -0.5

N_BRANCHES = 3
IN_SPLITS = (MLA_Q_LORA, MLA_KV_LORA, MLA_ROPE, POOL_WIDTH, SWA_Q_HEADS * SWA_HEAD_DIM, SWA_KV_HEADS * SWA_HEAD_DIM, SWA_KV_HEADS * SWA_HEAD_DIM, N_BRANCHES * D_MODEL)
IN_OFFSETS = tuple(sum(IN_SPLITS[:j]) for j in range(len(IN_SPLITS) + 1))
IN_WIDTH = IN_OFFSETS[-1]

N_EXPERTS = 64
TOP_K = 8
N_GROUPS = 8
TOPK_GROUPS = 4
EXPERTS_PER_GROUP = N_EXPERTS // N_GROUPS
D_EXPERT = 256
D_SHARED = 256
ROUTED_SCALE = 2.5
MOE_BLOCK = 128

kernel_name = "hybrid_mla_pool_swa_moe_dit"


def rmsnorm(x, g):
    xf = x.astype(jnp.float32)
    y = xf * lax.rsqrt(jnp.mean(xf * xf, axis=-1, keepdims=True) + NORM_EPS)
    return (y * g.astype(jnp.float32)).astype(x.dtype)


def axial_rope_tables(n_tokens, rot_dim):
    rows = n_tokens // GRID_W
    t = jnp.arange(rows * GRID_W)
    row = (t // GRID_W).astype(jnp.float32)
    col = (t % GRID_W).astype(jnp.float32)
    n_freq = rot_dim // 4
    inv_freq = ROPE_BASE ** (-jnp.arange(n_freq, dtype=jnp.float32) / n_freq)
    ang_r = row[:, None] * inv_freq[None, :]
    ang_c = col[:, None] * inv_freq[None, :]
    return (jnp.cos(ang_r), jnp.sin(ang_r), jnp.cos(ang_c), jnp.sin(ang_c))


def apply_axial_rope(x, tabs):
    cos_r, sin_r, cos_c, sin_c = (t[None, :, None, :].astype(x.dtype) for t in tabs)
    r1, r2, c1, c2 = jnp.split(x, 4, axis=-1)
    return jnp.concatenate([r1 * cos_r - r2 * sin_r, r2 * cos_r + r1 * sin_r,
                            c1 * cos_c - c2 * sin_c, c2 * cos_c + c1 * sin_c], axis=-1)


def in_proj(h, w_in, first, last):
    y = h @ w_in[:, IN_OFFSETS[first]:IN_OFFSETS[last]]
    cuts = [IN_OFFSETS[j] - IN_OFFSETS[first] for j in range(first + 1, last)]
    return jnp.split(y, cuts, axis=-1)


def mla_queries(cq, g_q, w_uq):
    B, L, _ = cq.shape
    q = (rmsnorm(cq, g_q) @ w_uq).reshape(B, L, MLA_HEADS, MLA_NOPE + MLA_ROPE)
    return q[..., :MLA_NOPE], q[..., MLA_NOPE:]


def mla_keys(ckv, g_kv, w_ukv):
    B, L, _ = ckv.shape
    kv = (rmsnorm(ckv, g_kv) @ w_ukv).reshape(B, L, MLA_HEADS, MLA_NOPE + MLA_V)
    return kv[..., :MLA_NOPE], kv[..., MLA_NOPE:]


def mla_attend(q_nope, q_rope, k_nope, k_rope, v):
    s = jnp.einsum('bqhd,bkhd->bhqk', q_nope, k_nope) + jnp.einsum('bqhd,bkd->bhqk', q_rope, k_rope)
    p = jax.nn.softmax(s.astype(jnp.float32) * MLA_SCALE, axis=-1).astype(v.dtype)
    return jnp.einsum('bhqk,bkhd->bqhd', p, v)


def mla_latent_attention(q_nope, q_rope, k_nope, k_rope, v, ck_nope, ck_rope, cv):
    B, S = q_nope.shape[:2]
    nb = S // ATTN_Q_BLOCK
    kn = jnp.concatenate([ck_nope, k_nope], axis=1)
    kr = jnp.concatenate([ck_rope, k_rope], axis=1)
    vv = jnp.concatenate([cv, v], axis=1)

    def to_blocks(t):
        return jnp.moveaxis(t.reshape((B, nb, ATTN_Q_BLOCK) + t.shape[2:]), 1, 0)

    out = lax.map(lambda qb: mla_attend(qb[0], qb[1], kn, kr, vv), (to_blocks(q_nope), to_blocks(q_rope)))
    return jnp.moveaxis(out, 0, 1).reshape(B, S, MLA_WIDTH)


def multiscale_pool(u, w_pool, pool_scale):
    B, L, _ = u.shape
    uf = u.astype(jnp.float32)
    cs = jnp.pad(jnp.cumsum(uf, axis=1), ((0, 0), (1, 0), (0, 0)))
    t = jnp.arange(L)
    outs = []
    for j, w in enumerate(POOL_WINDOWS):
        lo = jnp.clip(t - w // 2, 0, L)
        hi = jnp.clip(t + w - w // 2, 0, L)
        cnt = (hi - lo).astype(jnp.float32)[None, :, None]
        sl = slice(j * POOL_GROUP_DIM, (j + 1) * POOL_GROUP_DIM)
        cs_g = cs[:, :, sl]
        outs.append((cs_g[:, hi] - cs_g[:, lo]) / cnt - uf[:, :, sl])
    pooled = jnp.concatenate(outs, axis=-1).astype(u.dtype).reshape(B, L, POOL_GROUPS, POOL_GROUP_DIM)
    mixed = jnp.einsum('blgc,gcd->blgd', pooled, w_pool).reshape(B, L, POOL_WIDTH)
    return mixed * pool_scale


def swa_latent_attention(q, k, v, kc, vc, sink):
    B, S = q.shape[:2]
    G = SWA_Q_HEADS // SWA_KV_HEADS
    nb = S // SWA_BLOCK
    qb = q.reshape(B, nb, SWA_BLOCK, SWA_KV_HEADS, G, SWA_HEAD_DIM)

    def band(t):
        tp = jnp.pad(t, ((0, 0), (SWA_BLOCK, SWA_BLOCK), (0, 0), (0, 0)))
        tp = tp.reshape(B, nb + 2, SWA_BLOCK, SWA_KV_HEADS, SWA_HEAD_DIM)
        return jnp.concatenate([tp[:, :-2], tp[:, 1:-1], tp[:, 2:]], axis=2)

    kb, vb = band(k), band(v)
    blk = jnp.arange(nb)[:, None, None]
    qpos = blk * SWA_BLOCK + jnp.arange(SWA_BLOCK)[None, :, None]
    kpos = (blk - 1) * SWA_BLOCK + jnp.arange(3 * SWA_BLOCK)[None, None, :]
    mask = (jnp.abs(qpos - kpos) <= SWA_WINDOW) & (kpos >= 0) & (kpos < S)
    s_band = jnp.einsum('bnqhgd,bnkhd->bnhgqk', qb, kb).astype(jnp.float32) * SWA_SCALE
    s_band = jnp.where(mask[None, :, None, None], s_band, -jnp.inf)
    s_ctx = jnp.einsum('bnqhgd,bchd->bnhgqc', qb, kc).astype(jnp.float32) * SWA_SCALE
    s_sink = jnp.broadcast_to(sink.astype(jnp.float32).reshape(1, 1, SWA_KV_HEADS, G, 1, 1), s_band.shape[:-1] + (1,))
    p = jax.nn.softmax(jnp.concatenate([s_band, s_ctx, s_sink], axis=-1), axis=-1).astype(v.dtype)
    n_band = 3 * SWA_BLOCK
    n_ctx = kc.shape[1]
    out = (jnp.einsum('bnhgqk,bnkhd->bnqhgd', p[..., :n_band], vb)
           + jnp.einsum('bnhgqc,bchd->bnqhgd', p[..., n_band:n_band + n_ctx], vc))
    return out.reshape(B, S, SWA_WIDTH)


def swa_context_attention(q, k, v, sink):
    B, C = q.shape[:2]
    G = SWA_Q_HEADS // SWA_KV_HEADS
    qg = q.reshape(B, C, SWA_KV_HEADS, G, SWA_HEAD_DIM)
    s = jnp.einsum('bqhgd,bkhd->bhgqk', qg, k).astype(jnp.float32) * SWA_SCALE
    s_sink = jnp.broadcast_to(sink.astype(jnp.float32).reshape(1, SWA_KV_HEADS, G, 1, 1), s.shape[:-1] + (1,))
    p = jax.nn.softmax(jnp.concatenate([s, s_sink], axis=-1), axis=-1)[..., :-1].astype(v.dtype)
    return jnp.einsum('bhgqk,bkhd->bqhgd', p, v).reshape(B, C, SWA_WIDTH)


def merge_branches(gate_logits, y_mla, y_pool, y_swa, w_br_mla, w_br_pool, w_br_swa, w_out):
    g_mla, g_pool, g_swa = jnp.split(jax.nn.sigmoid(gate_logits), N_BRANCHES, axis=-1)
    merged = g_mla * (y_mla @ w_br_mla) + g_pool * (y_pool @ w_br_pool) + g_swa * (y_swa @ w_br_swa)
    return merged @ w_out


def token_mixers(h_lat, h_ctx, ctx_out, w_in, g_mla_q, g_mla_kv, w_mla_uq, w_mla_ukv, w_pool, pool_scale,
                 swa_sink, w_br_mla, w_br_pool, w_br_swa, w_out, rope_mla, rope_swa):
    B, S, _ = h_lat.shape
    C = h_ctx.shape[1]
    cq, ckv, kr, u, qs, ks, vs, gl = in_proj(h_lat, w_in, 0, 8)
    q_nope, q_rope = mla_queries(cq, g_mla_q, w_mla_uq)
    k_nope, v_mla = mla_keys(ckv, g_mla_kv, w_mla_ukv)
    q_rope = apply_axial_rope(q_rope, rope_mla)
    k_rope = apply_axial_rope(kr[:, :, None, :], rope_mla)[:, :, 0, :]
    qs = apply_axial_rope(qs.reshape(B, S, SWA_Q_HEADS, SWA_HEAD_DIM), rope_swa)
    ks = apply_axial_rope(ks.reshape(B, S, SWA_KV_HEADS, SWA_HEAD_DIM), rope_swa)
    vs = vs.reshape(B, S, SWA_KV_HEADS, SWA_HEAD_DIM)
    if ctx_out:
        ccq, cckv, ckr, cu, cqs, cks, cvs, cgl = in_proj(h_ctx, w_in, 0, 8)
    else:
        cckv, ckr = in_proj(h_ctx, w_in, 1, 3)
        cks, cvs = in_proj(h_ctx, w_in, 5, 7)
    ck_nope, cv_mla = mla_keys(cckv, g_mla_kv, w_mla_ukv)
    cks = cks.reshape(B, C, SWA_KV_HEADS, SWA_HEAD_DIM)
    cvs = cvs.reshape(B, C, SWA_KV_HEADS, SWA_HEAD_DIM)
    y_mla = mla_latent_attention(q_nope, q_rope, k_nope, k_rope, v_mla, ck_nope, ckr, cv_mla)
    y_pool = multiscale_pool(u, w_pool, pool_scale)
    y_swa = swa_latent_attention(qs, ks, vs, cks, cvs, swa_sink)
    y_lat = merge_branches(gl, y_mla, y_pool, y_swa, w_br_mla, w_br_pool, w_br_swa, w_out)
    if not ctx_out:
        return y_lat, None
    cq_nope, cq_rope = mla_queries(ccq, g_mla_q, w_mla_uq)
    cy_mla = mla_attend(cq_nope, cq_rope, ck_nope, ckr, cv_mla).reshape(B, C, MLA_WIDTH)
    cy_pool = multiscale_pool(cu, w_pool, pool_scale)
    cy_swa = swa_context_attention(cqs.reshape(B, C, SWA_Q_HEADS, SWA_HEAD_DIM), cks, cvs, swa_sink)
    y_ctx = merge_branches(cgl, cy_mla, cy_pool, cy_swa, w_br_mla, w_br_pool, w_br_swa, w_out)
    return y_lat, y_ctx


def moe_ffn(h, w_router, router_bias, w_eg, w_eu, w_ed, w_sg, w_su, w_sd):
    T, D = h.shape
    scores = jax.nn.sigmoid((h @ w_router).astype(jnp.float32))
    sel = scores + router_bias.astype(jnp.float32)
    grp_score = lax.top_k(sel.reshape(T, N_GROUPS, EXPERTS_PER_GROUP), 2)[0].sum(-1)
    grp_idx = lax.top_k(grp_score, TOPK_GROUPS)[1]
    grp_mask = jnp.any(grp_idx[:, :, None] == jnp.arange(N_GROUPS)[None, None, :], axis=1)
    sel = jnp.where(jnp.repeat(grp_mask, EXPERTS_PER_GROUP, axis=1), sel, -jnp.inf)
    idx = lax.top_k(sel, TOP_K)[1]
    wts = jnp.take_along_axis(scores, idx, axis=1)
    wts = wts / jnp.sum(wts, axis=-1, keepdims=True) * ROUTED_SCALE
    A = T * TOP_K
    flat_e = idx.reshape(-1)
    flat_w = wts.reshape(-1)
    order = jnp.argsort(flat_e)
    sorted_e = flat_e[order]
    counts = jnp.bincount(flat_e, length=N_EXPERTS)
    padded = (counts + MOE_BLOCK - 1) // MOE_BLOCK * MOE_BLOCK
    pad_end = jnp.cumsum(padded)
    pad_start = pad_end - padded
    start = jnp.cumsum(counts) - counts
    dest = pad_start[sorted_e] + jnp.arange(A) - start[sorted_e]
    n_rows = -(-(A + N_EXPERTS * (MOE_BLOCK - 1)) // MOE_BLOCK) * MOE_BLOCK
    n_blocks = n_rows // MOE_BLOCK
    row_tok = jnp.full((n_rows,), T, jnp.int32).at[dest].set((order // TOP_K).astype(jnp.int32))
    row_w = jnp.zeros((n_rows,), h.dtype).at[dest].set(flat_w[order].astype(h.dtype))
    block_e = jnp.minimum(jnp.searchsorted(pad_end, jnp.arange(n_blocks) * MOE_BLOCK, side='right'), N_EXPERTS - 1)
    h_pad = jnp.concatenate([h, jnp.zeros((1, D), h.dtype)], axis=0)

    def expert_block(args):
        tok, e = args
        xb = h_pad[tok]
        return (jax.nn.silu(xb @ w_eg[e]) * (xb @ w_eu[e])) @ w_ed[e]

    y = lax.map(expert_block, (row_tok.reshape(n_blocks, MOE_BLOCK), block_e)).reshape(n_rows, D)
    routed = jnp.zeros((T + 1, D), h.dtype).at[row_tok].add(y * row_w[:, None])[:T]
    shared = (jax.nn.silu(h @ w_sg) * (h @ w_su)) @ w_sd
    return routed + shared


def setup_inputs(seed: int = 0) -> dict:
    key = jax.random.key(seed)
    ks = jax.random.split(key, 32)
    f32 = jnp.float32

    def nrm(k, shape, scale):
        return jax.random.normal(k, shape, f32) * scale

    L = DEPTH
    return {
        "x": nrm(ks[0], (BATCH, SEQ, D_MODEL), 1.0),
        "c": nrm(ks[1], (BATCH, D_MODEL), 1.0),
        "ctx": nrm(ks[2], (BATCH, CTX_LEN, D_MODEL), 1.0),
        "c_ctx": nrm(ks[3], (D_MODEL,), 1.0),
        "w_mod": nrm(ks[4], (L, D_MODEL, N_MOD * D_MODEL), 0.5 * D_MODEL ** -0.5),
        "b_mod": nrm(ks[5], (L, N_MOD * D_MODEL), 0.02),
        "g_mix": 1.0 + nrm(ks[6], (L, D_MODEL), 0.05),
        "g_ffn": 1.0 + nrm(ks[7], (L, D_MODEL), 0.05),
        "w_in": nrm(ks[8], (L, D_MODEL, IN_WIDTH), D_MODEL ** -0.5),
        "g_mla_q": 1.0 + nrm(ks[9], (L, MLA_Q_LORA), 0.05),
        "g_mla_kv": 1.0 + nrm(ks[10], (L, MLA_KV_LORA), 0.05),
        "w_mla_uq": nrm(ks[11], (L, MLA_Q_LORA, MLA_HEADS * (MLA_NOPE + MLA_ROPE)), MLA_Q_LORA ** -0.5),
        "w_mla_ukv": nrm(ks[12], (L, MLA_KV_LORA, MLA_HEADS * (MLA_NOPE + MLA_V)), MLA_KV_LORA ** -0.5),
        "w_pool": nrm(ks[13], (L, POOL_GROUPS, POOL_GROUP_DIM, POOL_GROUP_DIM), POOL_GROUP_DIM ** -0.5),
        "pool_scale": 1.0 + nrm(ks[14], (L, POOL_WIDTH), 0.1),
        "swa_sink": nrm(ks[15], (L, SWA_Q_HEADS), 0.5),
        "w_br_mla": nrm(ks[16], (L, MLA_WIDTH, D_MODEL), MLA_WIDTH ** -0.5),
        "w_br_pool": nrm(ks[17], (L, POOL_WIDTH, D_MODEL), POOL_WIDTH ** -0.5),
        "w_br_swa": nrm(ks[18], (L, SWA_WIDTH, D_MODEL), SWA_WIDTH ** -0.5),
        "w_out": nrm(ks[19], (L, D_MODEL, D_MODEL), D_MODEL ** -0.5),
        "w_router": nrm(ks[20], (L, D_MODEL, N_EXPERTS), D_MODEL ** -0.5),
        "router_bias": nrm(ks[21], (L, N_EXPERTS), 0.01),
        "w_exp_gate": nrm(ks[22], (L, N_EXPERTS, D_MODEL, D_EXPERT), D_MODEL ** -0.5),
        "w_exp_up": nrm(ks[23], (L, N_EXPERTS, D_MODEL, D_EXPERT), D_MODEL ** -0.5),
        "w_exp_down": nrm(ks[24], (L, N_EXPERTS, D_EXPERT, D_MODEL), D_EXPERT ** -0.5),
        "w_sh_gate": nrm(ks[25], (L, D_MODEL, D_SHARED), D_MODEL ** -0.5),
        "w_sh_up": nrm(ks[26], (L, D_MODEL, D_SHARED), D_MODEL ** -0.5),
        "w_sh_down": nrm(ks[27], (L, D_SHARED, D_MODEL), D_SHARED ** -0.5),
        "g_final": 1.0 + nrm(ks[28], (D_MODEL,), 0.05),
    }


def reference(x, c, ctx, c_ctx, w_mod, b_mod, g_mix, g_ffn, w_in, g_mla_q, g_mla_kv, w_mla_uq, w_mla_ukv,
              w_pool, pool_scale, swa_sink, w_br_mla, w_br_pool, w_br_swa, w_out, w_router, router_bias,
              w_exp_gate, w_exp_up, w_exp_down, w_sh_gate, w_sh_up, w_sh_down, g_final):
    B, S, D = x.shape
    C = ctx.shape[1]
    rope_mla = axial_rope_tables(S, MLA_ROPE)
    rope_swa = axial_rope_tables(S, SWA_HEAD_DIM)
    xc = ctx
    for i in range(DEPTH):
        last = i == DEPTH - 1
        mod_lat = (jax.nn.silu(c) @ w_mod[i] + b_mod[i])[:, None, :]
        mod_ctx = (jax.nn.silu(c_ctx) @ w_mod[i] + b_mod[i])[None, None, :]
        sh1, sc1, gt1, sh2, sc2, gt2 = jnp.split(mod_lat, N_MOD, axis=-1)
        csh1, csc1, cgt1, csh2, csc2, cgt2 = jnp.split(mod_ctx, N_MOD, axis=-1)
        h_lat = rmsnorm(x, g_mix[i]) * (1 + sc1) + sh1
        h_ctx = rmsnorm(xc, g_mix[i]) * (1 + csc1) + csh1
        y_lat, y_ctx = token_mixers(h_lat, h_ctx, not last, w_in[i], g_mla_q[i], g_mla_kv[i], w_mla_uq[i],
                                    w_mla_ukv[i], w_pool[i], pool_scale[i], swa_sink[i], w_br_mla[i],
                                    w_br_pool[i], w_br_swa[i], w_out[i], rope_mla, rope_swa)
        x = x + gt1 * y_lat
        f_lat = (rmsnorm(x, g_ffn[i]) * (1 + sc2) + sh2).reshape(B * S, D)
        moe_args = (w_router[i], router_bias[i], w_exp_gate[i], w_exp_up[i], w_exp_down[i],
                    w_sh_gate[i], w_sh_up[i], w_sh_down[i])
        if last:
            x = x + gt2 * moe_ffn(f_lat, *moe_args).reshape(B, S, D)
        else:
            xc = xc + cgt1 * y_ctx
            f_ctx = (rmsnorm(xc, g_ffn[i]) * (1 + csc2) + csh2).reshape(B * C, D)
            f_out = moe_ffn(jnp.concatenate([f_lat, f_ctx], axis=0), *moe_args)
            x = x + gt2 * f_out[:B * S].reshape(B, S, D)
            xc = xc + cgt2 * f_out[B * S:].reshape(B, C, D)
    return rmsnorm(x, g_final)
```

```cpp
#include <hip/hip_runtime.h>
#include <cstdio>
#include <cstdint>

#ifndef KL_LAUNCH_MODE
#define KL_LAUNCH_MODE 1
#endif

#define LAS __attribute__((address_space(3)))
typedef unsigned short bf16_t;
typedef short bf16x8 __attribute__((ext_vector_type(8)));
typedef short s16x4 __attribute__((ext_vector_type(4)));
typedef float f32x4 __attribute__((ext_vector_type(4)));
typedef float f32x16 __attribute__((ext_vector_type(16)));
typedef unsigned u32x4 __attribute__((ext_vector_type(4)));
typedef int i32x4 __attribute__((ext_vector_type(4)));
typedef int i32x8 __attribute__((ext_vector_type(8)));
typedef unsigned u32x2 __attribute__((ext_vector_type(2)));
typedef float f32x2_t __attribute__((ext_vector_type(2)));
typedef __bf16 bf16x2_t __attribute__((ext_vector_type(2)));

constexpr int DM = 1024, NB = 4, SEQ = 4096, CTXL = 256, DEPTH = 2;
constexpr int TL = NB * SEQ;
constexpr int TC = NB * CTXL;
constexpr int TT = TL + TC;
constexpr int NIN = 5024, NINP = 5120;
constexpr int OFF_CQ = 0, OFF_CKV = 384, OFF_KR = 640, OFF_U = 672, OFF_QS = 1184, OFF_KS = 1696, OFF_VS = 1824, OFF_GL = 1952;
constexpr int NEXP = 64, TOPK = 8, DEXP = 256;
constexpr int MAXROWS = 155648;
constexpr int MAXTILES = MAXROWS / 256;
constexpr float NORM_EPS = 1e-6f;
constexpr float LOG2E = 1.4426950408889634f;
constexpr float MLA_QSCALE = 0.10206207261596577f * LOG2E;
constexpr float SWA_QSCALE = 0.125f * LOG2E;

constexpr size_t al256(size_t x) { return (x + 255) & ~(size_t)255; }
constexpr size_t WS_CTL = 0;
constexpr size_t CTL_BYTES = 65536;
constexpr int CW_BAR = 0;
constexpr int CW_CNT = 4096;
constexpr size_t WS_MOD = WS_CTL + CTL_BYTES;
constexpr size_t WS_TABM = WS_MOD + al256((size_t)DEPTH * 5 * 6144 * 4);
constexpr size_t WS_TABS = WS_TABM + 4096;
constexpr size_t WS_MISC = WS_TABS + 8192;
constexpr size_t WS_TILEE = WS_MISC + 256;
constexpr size_t WS_WSM = WS_TILEE + al256(MAXTILES * 4);
constexpr size_t WO_IN = 0;
constexpr size_t WO_UQ = WO_IN + (size_t)NINP * 1024 * 2;
constexpr size_t WO_K = WO_UQ + (size_t)768 * 384 * 2;
constexpr size_t WO_V = WO_K + (size_t)512 * 256 * 2;
constexpr size_t WO_COMB = WO_V + (size_t)512 * 256 * 2;
constexpr size_t WO_BRM = WO_COMB + (size_t)1024 * 512 * 2;
constexpr size_t WO_BRS = WO_BRM + (size_t)1024 * 512 * 2;
constexpr size_t WO_OUT = WO_BRS + (size_t)1024 * 512 * 2;
constexpr size_t WO_RS = WO_OUT + (size_t)1024 * 1024 * 2;
constexpr size_t WO_SD = WO_RS + (size_t)768 * 1024 * 2;
constexpr size_t WO_G8 = WO_SD + (size_t)1024 * 256 * 2;
constexpr size_t WO_I8 = WO_G8 + (size_t)3072 * 1024;
constexpr size_t WSM_LAYER = WO_I8 + (size_t)(2048 + 64) * 1024;
constexpr size_t WS_WGU = WS_WSM + DEPTH * WSM_LAYER;
constexpr size_t WS_WDN = WS_WGU + (size_t)NEXP * 512 * 1024 * 2;
constexpr size_t WS_X = WS_WDN + (size_t)NEXP * 1024 * 256 * 2;
constexpr size_t WS_H8 = WS_X + (size_t)TT * 1024 * 2;
constexpr size_t WS_PTOK = WS_X + (size_t)TT * 1024 * 3;
constexpr size_t WS_PWT = WS_PTOK + (size_t)NEXP * TT * 4;
constexpr size_t WS_LOGIT = WS_X + (size_t)TT * 1024 * 4;
static_assert(WS_PWT + (size_t)NEXP * TT * 4 + 4096 <= WS_LOGIT, "expert lists do not fit");
constexpr size_t WS_LOGIT2 = WS_LOGIT + (size_t)TT * 64 * 4;
constexpr size_t WS_TOKE = WS_LOGIT2 + (size_t)TT * 64 * 4;
constexpr size_t WS_TOKP = WS_TOKE + (size_t)TT * 8 * 4;
constexpr size_t WS_TOKW = WS_TOKP + (size_t)TT * 8 * 4;
constexpr size_t WS_TOKR = WS_TOKW + (size_t)TT * 8 * 4;
constexpr size_t WS_ROWT = WS_TOKR + (size_t)TT * 8 * 4;
constexpr size_t WS_ROWW = WS_ROWT + (size_t)MAXROWS * 4;
constexpr size_t WS_ACT = al256(WS_ROWW + (size_t)MAXROWS * 4);
constexpr size_t A_H = 0;
constexpr size_t A_SEG = A_H + (size_t)TT * 1024 * 2;
constexpr size_t A_CQ = A_SEG;
constexpr size_t A_CKV = A_CQ + (size_t)TT * 384 * 2;
constexpr size_t A_KR = A_CKV + (size_t)TT * 256 * 2;
constexpr size_t A_U = A_KR + (size_t)TT * 32 * 2;
constexpr size_t A_QSR = A_U + (size_t)TT * 512 * 2;
constexpr size_t A_KSR = A_QSR + (size_t)TT * 512 * 2;
constexpr size_t A_SEGEND = A_KSR + (size_t)TT * 128 * 2;
constexpr size_t A_QRAW = A_SEG;
constexpr size_t A_Q = A_H;
constexpr size_t A_YO = A_SEG;
constexpr size_t A_GATES = A_SEGEND;
constexpr size_t A_F = A_GATES;
constexpr size_t A_HS = A_F + al256((size_t)(TT + 1) * 1024 * 2);
constexpr size_t A_YS = A_HS + (size_t)TT * 256 * 2;
constexpr size_t A_F8 = A_YS + (size_t)TT * 1024 * 2;
constexpr size_t A_YH0 = A_YS + (size_t)TT * 1024 * 2;
constexpr size_t A_CQN = A_GATES + (size_t)TT * 3072 * 2;
constexpr size_t A_CKVN = A_CQN + (size_t)TT * 384 * 2;
constexpr size_t A_POOL = A_CKVN + (size_t)TT * 256 * 2;
constexpr size_t A_QS = A_POOL + (size_t)TT * 512 * 2;
constexpr size_t A_KS = A_QS + (size_t)TT * 512 * 2;
constexpr size_t A_VST = A_KS + (size_t)TT * 128 * 2;
constexpr size_t A_K = A_VST + (size_t)256 * TT * 2;
constexpr size_t A_VT = A_K + (size_t)TT * 768 * 2;
constexpr size_t A_YMLA = A_VT + (size_t)512 * TT * 2;
constexpr size_t A_YSWA = A_YMLA + (size_t)TT * 512 * 2;
constexpr size_t A_END = A_YSWA + (size_t)TT * 512 * 2;
constexpr size_t A_HMID = A_H;
static_assert(A_HMID + (size_t)MAXROWS * 256 * 2 <= A_GATES, "hmid overlaps f");
static_assert(A_YH0 + (size_t)MAXROWS * 512 * 2 <= A_END, "Y half does not fit");
static_assert(A_Q + (size_t)TT * 768 * 2 <= A_SEG, "Q does not fit");
constexpr size_t WS_END = WS_ACT + A_END;

#define XB_TMO      128
#define XB_XCNT(j)  (256  + 64 * (j))
#define XB_XSUB(j)  (1280 + 64 * (j))
#define XB_XGEN(j)  (2304 + 64 * (j))
#define XB_TOP      3328
#define XB_TOPGEN   3392
#define XCD_BAR_WORDS 3456
#define XB_SPIN_CAP (1u << 18)
__device__ __forceinline__ unsigned xb_ld(unsigned* p)              { return __hip_atomic_load(p, __ATOMIC_RELAXED, __HIP_MEMORY_SCOPE_AGENT); }
__device__ __forceinline__ unsigned xb_add(unsigned* p, unsigned v) { return __hip_atomic_fetch_add(p, v, __ATOMIC_RELAXED, __HIP_MEMORY_SCOPE_AGENT); }
__device__ __forceinline__ unsigned xb_xcc_id() { return (unsigned)__builtin_amdgcn_s_getreg((3 << 11) | 20) & 0xFu; }
#define XB_SPIN(cond, bar) do { unsigned _sp = 0; while (cond) { __builtin_amdgcn_s_sleep(1); \
    if ((++_sp & 255u) == 0u) { if (xb_ld(&(bar)[XB_TMO])) break; if (_sp > XB_SPIN_CAP) { atomicAdd(&(bar)[XB_TMO], 1u); break; } } } } while (0)
struct XcdBarrier { unsigned* bar; unsigned x; volatile LAS unsigned* st; };
__device__ __forceinline__ XcdBarrier xcd_barrier_post(unsigned* bar, volatile LAS unsigned* st) {
    XcdBarrier b; b.bar = bar; b.x = xb_xcc_id(); b.st = st;
    if (threadIdx.x == 0) (void)xb_add(&bar[XB_XCNT(b.x)], 1u);
    return b;
}
__device__ __forceinline__ void xcd_barrier_complete(unsigned* bar, unsigned x, unsigned& nloc, unsigned& nx) {
    const unsigned G = gridDim.x * gridDim.y * gridDim.z;
    unsigned sum, cnt, mine, sp = 0u;
    for (;;) {
        sum = 0u; cnt = 0u; mine = 0u;
#pragma unroll
        for (unsigned j = 0; j < 16; ++j) { const unsigned c = xb_ld(&bar[XB_XCNT(j)]); sum += c; cnt += (c > 0u) ? 1u : 0u; mine = (j == x) ? c : mine; }
        if (sum == G) break;
        __builtin_amdgcn_s_sleep(1);
        if ((++sp & 255u) == 0u) { if (xb_ld(&bar[XB_TMO])) break; if (sp > XB_SPIN_CAP) { atomicAdd(&bar[XB_TMO], 1u); break; } }
    }
    nloc = mine > 0u ? mine : 1u; nx = cnt > 0u ? cnt : 1u;
}
__device__ __forceinline__ void xcd_barrier(const XcdBarrier& b) {
    asm volatile("s_waitcnt vmcnt(0)" ::: "memory");
    __syncthreads();
    if (threadIdx.x == 0) {
        unsigned* bar = b.bar;
        __builtin_amdgcn_s_waitcnt(0);
        unsigned nloc = b.st[0], nx = b.st[1];
        if (nloc == 0u) { xcd_barrier_complete(bar, b.x, nloc, nx); b.st[0] = nloc; b.st[1] = nx; }
        const unsigned old = xb_add(&bar[XB_XSUB(b.x)], 1u);
        const unsigned gen = old / nloc;
        if (old + 1u == (gen + 1u) * nloc) {
            __builtin_amdgcn_fence(__ATOMIC_RELEASE, "agent");
            asm volatile("s_waitcnt vmcnt(0)" ::: "memory");
            const unsigned og = xb_add(&bar[XB_TOP], 1u);
            const unsigned tg = og / nx;
            if (og + 1u == (tg + 1u) * nx) xb_add(&bar[XB_TOPGEN], 1u);
            else XB_SPIN(xb_ld(&bar[XB_TOPGEN]) == tg, bar);
            __builtin_amdgcn_fence(__ATOMIC_ACQUIRE, "agent");
            xb_add(&bar[XB_XGEN(b.x)], 1u);
            asm volatile("s_waitcnt vmcnt(0)" ::: "memory");
        } else {
            XB_SPIN(xb_ld(&bar[XB_XGEN(b.x)]) == gen, bar);
            __builtin_amdgcn_fence(__ATOMIC_ACQUIRE, "agent");
            asm volatile("s_waitcnt vmcnt(0)" ::: "memory");
        }
    }
    __syncthreads();
}

__device__ __forceinline__ unsigned cvtpk(float lo, float hi) { f32x2_t v = {lo, hi}; bf16x2_t b = __builtin_convertvector(v, bf16x2_t); return __builtin_bit_cast(unsigned, b); }
__device__ __forceinline__ bf16_t f2bf(float f) { return (bf16_t)(cvtpk(f, 0.f) & 0xffffu); }
__device__ __forceinline__ float bflo(unsigned w) { return __uint_as_float(w << 16); }
__device__ __forceinline__ float bfhi(unsigned w) { return __uint_as_float(w & 0xffff0000u); }
__device__ __forceinline__ float bf2f(bf16_t b) { return __uint_as_float(((unsigned)b) << 16); }
__device__ __forceinline__ void unpack8(const u32x4& w, float (&a)[8]) { a[0] = bflo(w.x); a[1] = bfhi(w.x); a[2] = bflo(w.y); a[3] = bfhi(w.y); a[4] = bflo(w.z); a[5] = bfhi(w.z); a[6] = bflo(w.w); a[7] = bfhi(w.w); }
__device__ __forceinline__ u32x4 packf8(const float (&a)[8]) { u32x4 w; w.x = cvtpk(a[0], a[1]); w.y = cvtpk(a[2], a[3]); w.z = cvtpk(a[4], a[5]); w.w = cvtpk(a[6], a[7]); return w; }
__device__ __forceinline__ float fast_sigmoid(float x) { return __builtin_amdgcn_rcpf(1.0f + __builtin_amdgcn_exp2f(-x * LOG2E)); }
__device__ __forceinline__ float fast_silu(float x) { return x * fast_sigmoid(x); }
__device__ __forceinline__ unsigned fp8x4(float a, float b, float c, float d) { int w = 0; w = __builtin_amdgcn_cvt_pk_fp8_f32(a, b, w, false); w = __builtin_amdgcn_cvt_pk_fp8_f32(c, d, w, true); return (unsigned)w; }
constexpr float A8_SCALE = 32.0f;
__device__ __forceinline__ float wave_sum(float v) {
#pragma unroll
    for (int o = 32; o > 0; o >>= 1) v += __shfl_xor(v, o);
    return v;
}
__device__ __forceinline__ unsigned ld_ctl(const unsigned* p) { return __hip_atomic_load(p, __ATOMIC_RELAXED, __HIP_MEMORY_SCOPE_AGENT); }
__device__ __forceinline__ int ld_ctl(const int* p) { return __hip_atomic_load(p, __ATOMIC_RELAXED, __HIP_MEMORY_SCOPE_AGENT); }
__device__ __forceinline__ void sincos_small(float a, float& s, float& c) {
    const float k = rintf(a * 0.63661977236758134f);
    float r = fmaf(k, -1.57079637050628662109375f, a);
    r = fmaf(k, 4.37113900018624283e-8f, r);
    const float r2 = r * r;
    const float sr = r + r * r2 * (-1.6666667163e-1f + r2 * (8.3333337680e-3f + r2 * (-1.9841270114e-4f + r2 * 2.7557314297e-6f)));
    const float cr = 1.0f + r2 * (-0.5f + r2 * (4.1666667908e-2f + r2 * (-1.3888889225e-3f + r2 * (2.4801587642e-5f - r2 * 2.7557314297e-7f))));
    const int q = ((int)k) & 3;
    s = (q == 0) ? sr : (q == 1) ? cr : (q == 2) ? -sr : -cr;
    c = (q == 0) ? cr : (q == 1) ? -sr : (q == 2) ? -cr : sr;
}
__device__ __forceinline__ int tok_modrow(int t) { return t < TL ? (t >> 12) : 4; }

namespace pg8 {
constexpr int BM = 256, BK = 64, HALF = 128, HTB = HALF * BK * 2, STAGE_BYTES = 8 * HTB, NXCD = 8, WGM = 8;
__host__ __device__ __forceinline__ int lds_byte(int r, int c) { const int st = (r >> 4) * 2 + (c >> 5), rr = r & 15, cc = c & 31, ob = rr * 64 + cc * 2; return st * 1024 + (ob ^ (((ob >> 9) & 1) << 5)); }
__host__ __device__ __forceinline__ void stage_rc(int b, int& R, int& C) { const int st = b / 1024, sb = b % 1024, swz = sb ^ (((sb >> 9) & 1) << 5); R = (st >> 1) * 16 + swz / 64; C = (st & 1) * 32 + (swz % 64) / 2; }
__host__ __device__ __forceinline__ int perm32(int rho) { const int n = rho >> 4, i = rho & 15; return 8 * (i >> 2) + 4 * n + (i & 3); }
struct Unit { int pm, pn, br; };
__device__ __forceinline__ bool static_next(int nM, int nN, int G, int c, int i, Unit& u) {
    const int nwg = nM * nN; const long L = (long)i * G + c; if (L >= nwg) return false;
    int wgid = (int)L; { const int q = nwg / NXCD, r = nwg % NXCD, xcd = wgid % NXCD, off = wgid / NXCD; wgid = (xcd < r ? xcd * (q + 1) : r * (q + 1) + (xcd - r) * q) + off; }
    const int nig = WGM * nN, gid = wgid / nig, fm = gid * WGM, gsz = (nM - fm) < WGM ? (nM - fm) : WGM;
    u.pm = fm + ((wgid % nig) % gsz); u.pn = (wgid % nig) / gsz; return true;
}
template <bool F8 = false, int SW_ = 0, int SX_ = 0> struct DenseT {
    static constexpr bool GATHER = false, FP8 = F8, HALFN = false; static constexpr int SW = SW_, SX = SX_;
    const bf16_t* A; const bf16_t* Bt; int nM, nN, K, G, c;
    __device__ __forceinline__ bool next(int i, Unit& u) const { return static_next(nM, nN, G, c, i, u); }
    __device__ __forceinline__ const char* a_base(const Unit& u) const { return (const char*)A + (size_t)u.pm * 256 * K * 2; }
    __device__ __forceinline__ const char* b_base(const Unit& u) const { return (const char*)Bt + (size_t)u.pn * 256 * K * 2; }
    __device__ __forceinline__ unsigned row_off(const Unit&, int) const { return 0u; }
};
typedef DenseT<> Dense;
template <bool GATH, bool F8 = false, int SW_ = 0x7F7F7F7F, int SX_ = 0x7F7F7F7F> struct Grouped {
    static constexpr bool GATHER = GATH, FP8 = F8, HALFN = false; static constexpr int SW = SW_, SX = SX_;
    const bf16_t* A; const bf16_t* W; size_t estride; int ncol0; const LAS int* tile_e; const LAS int* tile_base; const LAS int* tile_nv; const int* ptok; int ntiles, nN, K, G, c;
    __device__ __forceinline__ bool next(int i, Unit& u) const { return static_next(ntiles, nN, G, c, i, u); }
    __device__ __forceinline__ const char* a_base(const Unit& u) const { return GATH ? (const char*)A : (const char*)A + (size_t)u.pm * 256 * K * 2; }
    __device__ __forceinline__ const char* b_base(const Unit& u) const { const int e = __builtin_amdgcn_readfirstlane(tile_e[u.pm]); return (const char*)W + ((size_t)e * estride + (size_t)(ncol0 + 256 * u.pn) * K) * 2; }
    __device__ __forceinline__ unsigned row_off(const Unit& u, int r) const { const int nv = tile_nv[u.pm]; const int tok = ptok[tile_base[u.pm] + (r < nv ? r : 0)]; return (unsigned)(r < nv ? tok : TT) * (unsigned)(K * 2); }
};

template <bool F8 = false, int SW_ = 0, int SX_ = 0> struct Merge3HT {
    static constexpr bool GATHER = false, FP8 = F8, HALFN = true; static constexpr int SW = SW_, SX = SX_;
    const bf16_t* A0; const bf16_t* A1; const bf16_t* A2; const bf16_t* B0; const bf16_t* B1; const bf16_t* B2; int nM, nN, K, G, c;
    __device__ __forceinline__ bool next(int i, Unit& u) const {
        const int j = i / 3; u.br = i - 3 * j;
        const int nwg = nM * nN; const long L = (long)j * G + c; if (L >= nwg) return false;
        int wgid = (int)L; { const int q = nwg / NXCD, r = nwg % NXCD, xcd = wgid % NXCD, off = wgid / NXCD; wgid = (xcd < r ? xcd * (q + 1) : r * (q + 1) + (xcd - r) * q) + off; }
        u.pm = wgid / nN; u.pn = wgid % nN; return true; }
    __device__ __forceinline__ const char* a_base(const Unit& u) const { const long d1 = (const char*)A1 - (const char*)A0, d2 = (const char*)A2 - (const char*)A0;
        return (const char*)A0 + (long)(u.br & 1) * d1 + (long)(u.br >> 1) * d2 + (size_t)u.pm * 256 * K * 2; }
    __device__ __forceinline__ const char* b_base(const Unit& u) const { const long d1 = (const char*)B1 - (const char*)B0, d2 = (const char*)B2 - (const char*)B0;
        return (const char*)B0 + (long)(u.br & 1) * d1 + (long)(u.br >> 1) * d2 + (size_t)u.pn * 128 * K * 2; }
    __device__ __forceinline__ unsigned row_off(const Unit&, int) const { return 0u; }
};

struct DenseH {
    static constexpr bool GATHER = false, FP8 = false, HALFN = true; static constexpr int SW = 0, SX = 0;
    const bf16_t* A; const bf16_t* Bt; int pm0, nM, nN, K, G, c;
    __device__ __forceinline__ bool next(int i, Unit& u) const { const long L = (long)i * G + c; if (c < 0 || L >= nM * nN) return false; u.pm = pm0 + (int)L / nN; u.pn = (int)L % nN; u.br = 0; return true; }
    __device__ __forceinline__ const char* a_base(const Unit& u) const { return (const char*)A + (size_t)u.pm * 256 * K * 2; }
    __device__ __forceinline__ const char* b_base(const Unit& u) const { return (const char*)Bt + (size_t)u.pn * 128 * K * 2; }
    __device__ __forceinline__ unsigned row_off(const Unit&, int) const { return 0u; }
};

#ifndef PG8_SP2
#define PG8_SP2 1
#endif
template <bool F8> struct Frag { bf16x8 k0, k1;
    __device__ __forceinline__ void load(const LAS unsigned char* p) { k0 = *(const LAS bf16x8*)p; k1 = *(const LAS bf16x8*)(p + 1024); } };
template <> struct Frag<true> { i32x8 w;
    __device__ __forceinline__ void load(const LAS unsigned char* p) { w = *(const LAS i32x8*)p; } };
template <class Epi, class Prob>
__device__ __forceinline__ void gemm_phase(LAS unsigned char* lds, const Prob& P, const Epi& E) {
    constexpr bool SP2 = PG8_SP2 != 0, ALIGN_EPI = PG8_SP2 != 0, HN = Prob::HALFN;
    const int tid = threadIdx.x, wid = __builtin_amdgcn_readfirstlane(tid >> 6), lane = tid & 63, wr = wid >> 2, wc = wid & 3, fr = lane & 15, fq = lane >> 4;
    const int K = P.K, nt = K / BK;
    int Rst[2]; unsigned voffA[2], voffB[2];
#pragma unroll
    for (int i = 0; i < 2; ++i) { int R, C; stage_rc(tid * 16 + i * 8192, R, C); const int Rb = (R & ~31) + perm32(R & 31); Rst[i] = R;
        voffA[i] = (unsigned)(R * K + C) * 2u; voffB[i] = (unsigned)(Rb * K + C) * 2u; if (Prob::GATHER) voffA[i] = (unsigned)C * 2u; }
    const size_t kstep = (size_t)(BK * 2);
    const size_t hstep = (size_t)HALF * K * 2;
    const size_t hstepA = Prob::GATHER ? 0 : hstep;
    const unsigned ldsw = (unsigned)wid * 1024u;
    const int aoff = Prob::FP8 ? lds_byte(wr * 64 + fr, fq * 16) : lds_byte(wr * 64 + fr, fq * 8), boff = Prob::FP8 ? lds_byte(wc * 32 + fr, fq * 16) : lds_byte(wc * 32 + fr, fq * 8);
#define PG8_SA(b, h) (((b) * 2 + (h)) * HTB)
#define PG8_SB(b, h) ((4 + (b) * 2 + (h)) * HTB)
#define PG8_STAGE(bufoff, gbase, voff) do { _Pragma("unroll") for (int _i = 0; _i < 2; ++_i) \
        __builtin_amdgcn_global_load_lds((const unsigned*)((const char*)(gbase) + (voff)[_i]), (LAS unsigned*)(lds + (bufoff) + ldsw + _i * 8192), 16, 0, 0); } while (0)
#define PG8_STAGEA(bufoff, gbase, h, nx) do { _Pragma("unroll") for (int _i = 0; _i < 2; ++_i) { \
        const unsigned _ro = Prob::GATHER ? ((nx) ? groN[h][_i] : groC[h][_i]) : 0u; \
        __builtin_amdgcn_global_load_lds((const unsigned*)(((const char*)(gbase) + (size_t)(h) * hstepA) + (unsigned)(_ro + voffA[_i])), (LAS unsigned*)(lds + (bufoff) + ldsw + _i * 8192), 16, 0, 0); } } while (0)
#define PG8_LDA(dst, b, h) do { _Pragma("unroll") for (int m = 0; m < 4; ++m) dst[m].load(lds + PG8_SA(b, h) + aoff + m * 2048); } while (0)
#define PG8_LDB(dst, b, h) do { _Pragma("unroll") for (int n = 0; n < 2; ++n) dst[n].load(lds + PG8_SB(b, h) + boff + n * 2048); } while (0)
#define PG8_MMA(ai, bj, At, Bt) do { __builtin_amdgcn_s_setprio(1); _Pragma("unroll") for (int m = 0; m < 4; ++m) _Pragma("unroll") for (int n = 0; n < 2; ++n) { \
        if constexpr (Prob::FP8) {   \
              \
            asm volatile("v_mfma_scale_f32_16x16x128_f8f6f4 %0, %1, %2, %0, %3, %3 op_sel_hi:[0,0,0]" : "+v"(acc[ai][bj][m][n]) : "v"(Bt[n].w), "v"(At[m].w), "v"(mxscale)); \
        } else { acc[ai][bj][m][n] = __builtin_amdgcn_mfma_f32_16x16x32_bf16(Bt[n].k0, At[m].k0, acc[ai][bj][m][n], 0, 0, 0); \
                 acc[ai][bj][m][n] = __builtin_amdgcn_mfma_f32_16x16x32_bf16(Bt[n].k1, At[m].k1, acc[ai][bj][m][n], 0, 0, 0); } } \
        __builtin_amdgcn_s_setprio(0); } while (0)
#define PG8_WAIT_V(n) asm volatile("s_waitcnt vmcnt(" #n ")" ::: "memory")
#define PG8_STAGE_B1(bufoff, gbase, voff) do { if constexpr (!HN) PG8_STAGE(bufoff, gbase, voff); } while (0)
#define PG8_LDB1(dst, b, h) do { if constexpr (!HN) PG8_LDB(dst, b, h); } while (0)
#define PG8_MMA1(ai, bj, At, Bt) do { if constexpr (!HN) PG8_MMA(ai, bj, At, Bt); } while (0)
#define PG8_WAIT_LOOP do { if constexpr (HN) PG8_WAIT_V(6); else PG8_WAIT_V(8); } while (0)
#define PG8_WAIT_L(n) asm volatile("s_waitcnt lgkmcnt(" #n ")" ::: "memory")
#define PG8_BAR __builtin_amdgcn_s_barrier()
#define PG8_SCHED __builtin_amdgcn_sched_barrier(0)
    Unit cur, nxt; int ui = 0;
    if (!P.next(0, cur)) return;
    f32x4 acc[2][2][4][2];
#pragma unroll
    for (int a = 0; a < 2; ++a)
#pragma unroll
        for (int b = 0; b < 2; ++b)
#pragma unroll
            for (int m = 0; m < 4; ++m)
#pragma unroll
                for (int n = 0; n < 2; ++n) acc[a][b][m][n] = (f32x4){0.f, 0.f, 0.f, 0.f};
    Frag<Prob::FP8> At[4], B0[2], B1[2];
    const int mxscale = Prob::SW;
    unsigned groC[2][2] = {{0u, 0u}, {0u, 0u}}, groN[2][2] = {{0u, 0u}, {0u, 0u}};
    if (Prob::GATHER) {
#pragma unroll
        for (int h = 0; h < 2; ++h)
#pragma unroll
            for (int i = 0; i < 2; ++i) groC[h][i] = P.row_off(cur, h * HALF + Rst[i]);
    }
    const char* cA = P.a_base(cur); const char* cB = P.b_base(cur);
    if constexpr (SP2) {
        PG8_STAGE(PG8_SB(0, 0), cB, voffB); PG8_STAGE_B1(PG8_SB(0, 1), cB + hstep, voffB); PG8_STAGEA(PG8_SA(0, 0), cA, 0, false); PG8_STAGEA(PG8_SA(0, 1), cA, 1, false);
        if (wr == 1) PG8_BAR;
        PG8_WAIT_V(2); PG8_BAR;
        PG8_STAGE(PG8_SB(1, 0), cB + kstep, voffB); PG8_STAGEA(PG8_SA(1, 0), cA + kstep, 0, false); PG8_STAGE_B1(PG8_SB(1, 1), cB + hstep + kstep, voffB);
        if constexpr (HN) PG8_WAIT_V(4); else PG8_WAIT_V(6);
        PG8_BAR;
    } else {
        PG8_STAGE(PG8_SB(0, 0), cB, voffB); PG8_STAGEA(PG8_SA(0, 0), cA, 0, false); PG8_STAGE(PG8_SB(0, 1), cB + hstep, voffB); PG8_STAGEA(PG8_SA(0, 1), cA, 1, false);
        if (wr == 1) PG8_BAR;
        PG8_WAIT_V(4); PG8_BAR;
        PG8_STAGE(PG8_SB(1, 0), cB + kstep, voffB); PG8_STAGEA(PG8_SA(1, 0), cA + kstep, 0, false); PG8_STAGE(PG8_SB(1, 1), cB + hstep + kstep, voffB);
        PG8_WAIT_V(6); PG8_BAR;
    }
    typename Epi::State est;
    for (;;) {
        const bool has_next = P.next(ui + 1, nxt);
        if constexpr (HN) E.prefetch(est, cur, wr, wc, fr, fq);
        const char* nA = has_next ? P.a_base(nxt) : cA; const char* nB = has_next ? P.b_base(nxt) : cB;
        if (Prob::GATHER) {
            const int pmn = has_next ? nxt.pm : cur.pm; Unit un; un.pm = pmn; un.pn = 0;
#pragma unroll
            for (int h = 0; h < 2; ++h)
#pragma unroll
                for (int i = 0; i < 2; ++i) groN[h][i] = P.row_off(un, h * HALF + Rst[i]);
        }
        for (int t = 0; t < nt; t += 2) {
            const bool last = (t == nt - 2);
            const char* a1 = cA + (size_t)(t + 1) * kstep;
            const char* a2 = last ? nA : cA + (size_t)(t + 2) * kstep; const char* b2 = last ? nB : cB + (size_t)(t + 2) * kstep;
            const char* a3 = a2 + kstep; const char* b3 = b2 + kstep;
            if constexpr (SP2) {
            PG8_LDB(B0, 0, 0); PG8_LDB1(B1, 0, 1); PG8_SCHED; PG8_LDA(At, 0, 0); PG8_STAGEA(PG8_SA(1, 1), a1, 1, false);
            PG8_WAIT_LOOP; PG8_WAIT_L(0); PG8_BAR; PG8_MMA(0, 0, At, B0); PG8_MMA1(0, 1, At, B1); PG8_BAR; PG8_SCHED;
            PG8_LDA(At, 0, 1); PG8_STAGE(PG8_SB(0, 0), b2, voffB); PG8_STAGE_B1(PG8_SB(0, 1), b2 + hstep, voffB); PG8_STAGEA(PG8_SA(0, 0), a2, 0, last);
            PG8_WAIT_LOOP; PG8_WAIT_L(0); PG8_BAR; PG8_MMA(1, 0, At, B0); PG8_MMA1(1, 1, At, B1); PG8_BAR; PG8_SCHED;
            PG8_LDB(B0, 1, 0); PG8_LDB1(B1, 1, 1); PG8_SCHED; PG8_LDA(At, 1, 0); PG8_STAGEA(PG8_SA(0, 1), a2, 1, last);
            PG8_WAIT_LOOP; PG8_WAIT_L(0); PG8_BAR; PG8_MMA(0, 0, At, B0); PG8_MMA1(0, 1, At, B1); PG8_BAR; PG8_SCHED;
            PG8_LDA(At, 1, 1); PG8_STAGE(PG8_SB(1, 0), b3, voffB); PG8_STAGE_B1(PG8_SB(1, 1), b3 + hstep, voffB); PG8_STAGEA(PG8_SA(1, 0), a3, 0, last);
            PG8_WAIT_LOOP; PG8_WAIT_L(0); PG8_BAR; PG8_MMA(1, 0, At, B0); PG8_MMA1(1, 1, At, B1); PG8_BAR; PG8_SCHED;
            } else {
            PG8_LDB(B0, 0, 0); PG8_SCHED; PG8_LDA(At, 0, 0); PG8_STAGEA(PG8_SA(1, 1), a1, 1, false);
            PG8_WAIT_L(8); PG8_BAR; PG8_WAIT_L(0); PG8_MMA(0, 0, At, B0); PG8_BAR; PG8_SCHED;
            PG8_LDB(B1, 0, 1); PG8_STAGE(PG8_SB(0, 0), b2, voffB);
            PG8_BAR; PG8_WAIT_L(0); PG8_MMA(0, 1, At, B1); PG8_BAR;
            PG8_LDA(At, 0, 1); PG8_STAGEA(PG8_SA(0, 0), a2, 0, last);
            PG8_BAR; PG8_WAIT_L(0); PG8_MMA(1, 0, At, B0); PG8_BAR; PG8_SCHED;
            PG8_STAGE(PG8_SB(0, 1), b2 + hstep, voffB);
            PG8_WAIT_V(6); PG8_BAR; PG8_MMA(1, 1, At, B1); PG8_BAR;
            PG8_LDB(B0, 1, 0); PG8_SCHED; PG8_LDA(At, 1, 0); PG8_STAGEA(PG8_SA(0, 1), a2, 1, last);
            PG8_WAIT_L(8); PG8_BAR; PG8_WAIT_L(0); PG8_MMA(0, 0, At, B0); PG8_BAR; PG8_SCHED;
            PG8_LDB(B1, 1, 1); PG8_STAGE(PG8_SB(1, 0), b3, voffB);
            PG8_BAR; PG8_WAIT_L(0); PG8_MMA(0, 1, At, B1); PG8_BAR;
            PG8_LDA(At, 1, 1); PG8_STAGEA(PG8_SA(1, 0), a3, 0, last);
            PG8_BAR; PG8_WAIT_L(0); PG8_MMA(1, 0, At, B0); PG8_BAR; PG8_SCHED;
            PG8_STAGE(PG8_SB(1, 1), b3 + hstep, voffB);
            PG8_WAIT_V(6); PG8_BAR; PG8_MMA(1, 1, At, B1); PG8_BAR;
                    }
        }
        if constexpr (ALIGN_EPI) { if (wr == 0) PG8_BAR; }
        if constexpr (Prob::FP8) asm volatile("s_nop 15\n\ts_nop 7" ::: "memory");
        if constexpr (HN) E.run(acc, est, cur, wr, wc, fr, fq); else E(acc, cur, wr, wc, fr, fq);
        if (!has_next) break;
#pragma unroll
        for (int a = 0; a < 2; ++a)
#pragma unroll
            for (int b = 0; b < 2; ++b)
#pragma unroll
                for (int m = 0; m < 4; ++m)
#pragma unroll
                    for (int n = 0; n < 2; ++n) acc[a][b][m][n] = (f32x4){0.f, 0.f, 0.f, 0.f};
        cur = nxt; cA = nA; cB = nB; ++ui;
        if (Prob::GATHER) {
#pragma unroll
            for (int h = 0; h < 2; ++h)
#pragma unroll
                for (int i = 0; i < 2; ++i) groC[h][i] = groN[h][i];
        }
        if constexpr (ALIGN_EPI) { if (wr == 1) PG8_BAR; }
    }
    PG8_WAIT_V(0);
    if constexpr (!ALIGN_EPI) { if (wr == 0) PG8_BAR; }
    PG8_BAR;
#undef PG8_SA
#undef PG8_SB
#undef PG8_STAGE
#undef PG8_STAGEA
#undef PG8_LDA
#undef PG8_LDB
#undef PG8_MMA
#undef PG8_WAIT_V
#undef PG8_STAGE_B1
#undef PG8_LDB1
#undef PG8_MMA1
#undef PG8_WAIT_LOOP
#undef PG8_WAIT_L
#undef PG8_BAR
#undef PG8_SCHED
}
}

#define EPI_ARGS const f32x4 (&acc)[2][2][4][2], const pg8::Unit& u, int wr, int wc, int fr, int fq
__device__ __forceinline__ u32x4 pack8(const f32x4& a, const f32x4& b) { u32x4 w; w.x = cvtpk(a[0], a[1]); w.y = cvtpk(a[2], a[3]); w.z = cvtpk(b[0], b[1]); w.w = cvtpk(b[2], b[3]); return w; }

struct EpiStore { struct State {};
    bf16_t* O; int ldo, lgin, gout, mrows;
    __device__ __forceinline__ void operator()(EPI_ARGS) const {
        const int row0 = u.pm * 256 + wr * 64 + fr;
#pragma unroll
        for (int bj = 0; bj < 2; ++bj) {
            const int c8 = u.pn * 256 + bj * 128 + wc * 32 + 8 * fq;
            const int dc = ((c8 >> lgin) * gout) + (c8 & ((1 << lgin) - 1));
#pragma unroll
            for (int ai = 0; ai < 2; ++ai)
#pragma unroll
                for (int m = 0; m < 4; ++m) { const int row = row0 + ai * 128 + m * 16;
                    *(u32x4*)(O + (size_t)row * ldo + dc) = pack8(acc[ai][bj][m][0], acc[ai][bj][m][1]); }
        }
    }
};
template <int W> __device__ __forceinline__ void rstd_rows(const bf16_t* src, int row0, int n, LAS float* tab, int lane) {
    constexpr int NV = W / 128;
    const int g = lane >> 4, sl = lane & 15;
    for (int i0 = 0; i0 < n; i0 += 16) {
        u32x4 w[4][NV];
#pragma unroll
        for (int p = 0; p < 4; ++p) { const bf16_t* q = src + (size_t)(row0 + i0 + 4 * p + g) * W + sl * (W / 16);
#pragma unroll
            for (int v = 0; v < NV; ++v) w[p][v] = *(const u32x4*)(q + 8 * v); }
#pragma unroll
        for (int p = 0; p < 4; ++p) { float ss = 0.f;
#pragma unroll
            for (int v = 0; v < NV; ++v)
#pragma unroll
                for (int e = 0; e < 4; ++e) { const float a = bflo(w[p][v][e]), b = bfhi(w[p][v][e]); ss += a * a + b * b; }
            ss += __shfl_xor(ss, 8); ss += __shfl_xor(ss, 4); ss += __shfl_xor(ss, 2); ss += __shfl_xor(ss, 1);
            if (sl == 0) tab[i0 + 4 * p + g] = rsqrtf(ss * (1.0f / (float)W) + NORM_EPS); }
    }
    asm volatile("s_waitcnt lgkmcnt(0)" ::: "memory");
}
template <int W> struct EpiStoreRS { struct State {};
    bf16_t* O; int ldo, lgin, gout; const bf16_t* src; LAS float* tab;
    __device__ __forceinline__ void operator()(EPI_ARGS) const {
        const int lane = fq * 16 + fr; LAS float* t = tab + wr * 128;
        { const int idx0 = wc * 32, ai0 = idx0 >> 6, loc0 = idx0 & 63; rstd_rows<W>(src, u.pm * 256 + ai0 * 128 + wr * 64 + loc0, 32, t + idx0, lane); }
        __syncthreads();
        const int row0 = u.pm * 256 + wr * 64 + fr;
#pragma unroll
        for (int bj = 0; bj < 2; ++bj) {
            const int c8 = u.pn * 256 + bj * 128 + wc * 32 + 8 * fq;
            const int dc = ((c8 >> lgin) * gout) + (c8 & ((1 << lgin) - 1));
#pragma unroll
            for (int ai = 0; ai < 2; ++ai)
#pragma unroll
                for (int m = 0; m < 4; ++m) { const int row = row0 + ai * 128 + m * 16; const float sc = t[ai * 64 + m * 16 + fr];
                    *(u32x4*)(O + (size_t)row * ldo + dc) = pack8(acc[ai][bj][m][0] * sc, acc[ai][bj][m][1] * sc); }
        }
    }
};
struct EpiStoreCS { struct State {};
    bf16_t* O; int ldo; const bf16_t* src; LAS float* tab;
    __device__ __forceinline__ void operator()(EPI_ARGS) const {
        const int wid = wr * 4 + wc, lane = fq * 16 + fr; LAS float* t = tab + 256 + wid * 64;
        rstd_rows<256>(src, u.pn * 256 + wc * 32, 32, t, lane); rstd_rows<256>(src, u.pn * 256 + 128 + wc * 32, 32, t + 32, lane);
        const int row0 = u.pm * 256 + wr * 64 + fr;
#pragma unroll
        for (int bj = 0; bj < 2; ++bj) {
            const int c8 = u.pn * 256 + bj * 128 + wc * 32 + 8 * fq;
            const f32x4 s0 = *(const LAS f32x4*)(t + bj * 32 + 8 * fq), s1 = *(const LAS f32x4*)(t + bj * 32 + 8 * fq + 4);
#pragma unroll
            for (int ai = 0; ai < 2; ++ai)
#pragma unroll
                for (int m = 0; m < 4; ++m) { const int row = row0 + ai * 128 + m * 16;
                    *(u32x4*)(O + (size_t)row * ldo + c8) = pack8(acc[ai][bj][m][0] * s0, acc[ai][bj][m][1] * s1); }
        }
    }
};
struct EpiResid { struct State {};
    bf16_t* X; const float* xlat; const float* xctx; const float* mod2;
    __device__ __forceinline__ void prefetch(State&, const pg8::Unit&, int, int, int, int) const {}
    __device__ __forceinline__ void run(const f32x4 (&acc)[2][2][4][2], State&, const pg8::Unit& u, int wr, int wc, int fr, int fq) const { body<1, 128>(acc, u, wr, wc, fr, fq); }
    __device__ __forceinline__ void operator()(EPI_ARGS) const { body<2, 256>(acc, u, wr, wc, fr, fq); }
    template <int NBJ, int TW> __device__ __forceinline__ void body(EPI_ARGS) const {
        const int t0 = u.pm * 256; const float* gt = mod2 + (size_t)tok_modrow(t0) * 6 * 1024;
        const int row0 = t0 + wr * 64 + fr;
#pragma unroll
        for (int bj = 0; bj < NBJ; ++bj) {
            const int c8 = u.pn * TW + bj * 128 + wc * 32 + 8 * fq;
            const f32x4 g0 = *(const f32x4*)(gt + c8), g1 = *(const f32x4*)(gt + c8 + 4);
#pragma unroll
            for (int ai = 0; ai < 2; ++ai)
#pragma unroll
                for (int m = 0; m < 4; ++m) { const int row = row0 + ai * 128 + m * 16; bf16_t* xo = X + (size_t)row * 1024 + c8;
                    f32x4 x0, x1;
                    if (xlat != nullptr) { const float* xr = (t0 < TL ? xlat + (size_t)row * 1024 : xctx + (size_t)(row - TL) * 1024) + c8; x0 = __builtin_nontemporal_load((const f32x4*)xr); x1 = __builtin_nontemporal_load((const f32x4*)(xr + 4)); }
                    else { const u32x4 w = *(const u32x4*)xo; x0 = (f32x4){bflo(w.x), bfhi(w.x), bflo(w.y), bfhi(w.y)}; x1 = (f32x4){bflo(w.z), bfhi(w.z), bflo(w.w), bfhi(w.w)}; }
                    *(u32x4*)xo = pack8(x0 + g0 * acc[ai][bj][m][0], x1 + g1 * acc[ai][bj][m][1]); }
        }
    }
};
struct EpiSeg { struct State {};
    unsigned char* act;
    __device__ __forceinline__ void operator()(EPI_ARGS) const {
        const int row0 = u.pm * 256 + wr * 64 + fr;
#pragma unroll
        for (int bj = 0; bj < 2; ++bj) {
            const int c32 = u.pn * 256 + bj * 128 + wc * 32;
            if (c32 >= OFF_VS) continue;
            size_t base; int ld, c0;
            if (c32 < OFF_CKV)      { base = A_CQ;  ld = 384; c0 = OFF_CQ; }
            else if (c32 < OFF_KR)  { base = A_CKV; ld = 256; c0 = OFF_CKV; }
            else if (c32 < OFF_U)   { base = A_KR;  ld = 32;  c0 = OFF_KR; }
            else if (c32 < OFF_QS)  { base = A_U;   ld = 512; c0 = OFF_U; }
            else if (c32 < OFF_KS)  { base = A_QS;  ld = 512; c0 = OFF_QS; }
            else                    { base = A_KSR; ld = 128; c0 = OFF_KS; }
            bf16_t* O = (bf16_t*)(act + base);
            const int dc = c32 - c0 + 8 * fq;
#pragma unroll
            for (int ai = 0; ai < 2; ++ai)
#pragma unroll
                for (int m = 0; m < 4; ++m) { const int row = row0 + ai * 128 + m * 16;
                    *(u32x4*)(O + (size_t)row * ld + dc) = pack8(acc[ai][bj][m][0], acc[ai][bj][m][1]); }
        }
    }
};
template <int PASS> struct EpiMerge { struct State {};
    bf16_t* out; const bf16_t* gates; int mrows;
    __device__ __forceinline__ void operator()(EPI_ARGS) const {
        const int row0 = u.pm * 256 + wr * 64 + fr;
#pragma unroll
        for (int bj = 0; bj < 2; ++bj) {
            const int c8 = u.pn * 256 + bj * 128 + wc * 32 + 8 * fq;
#pragma unroll
            for (int ai = 0; ai < 2; ++ai)
#pragma unroll
                for (int m = 0; m < 4; ++m) { const int row = row0 + ai * 128 + m * 16;
                    const u32x4 g = *(const u32x4*)(gates + (size_t)row * 3072 + PASS * 1024 + c8);
                    f32x4 v0 = acc[ai][bj][m][0], v1 = acc[ai][bj][m][1];
                    v0[0] *= bflo(g.x); v0[1] *= bfhi(g.x); v0[2] *= bflo(g.y); v0[3] *= bfhi(g.y);
                    v1[0] *= bflo(g.z); v1[1] *= bfhi(g.z); v1[2] *= bflo(g.w); v1[3] *= bfhi(g.w);
                    bf16_t* op = out + (size_t)row * 1024 + c8;
                    if (PASS > 0) { const u32x4 p = *(const u32x4*)op;
                        v0[0] += bflo(p.x); v0[1] += bfhi(p.x); v0[2] += bflo(p.y); v0[3] += bfhi(p.y);
                        v1[0] += bflo(p.z); v1[1] += bfhi(p.z); v1[2] += bflo(p.w); v1[3] += bfhi(p.w); }
                    *(u32x4*)op = pack8(v0, v1); }
        }
    }
};
__device__ __forceinline__ void swap16_pair(u32x2& x, u32x2& y) {
    auto r0 = __builtin_amdgcn_permlane16_swap(x.x, y.x, false, false); x.x = r0[0]; y.x = r0[1];
    auto r1 = __builtin_amdgcn_permlane16_swap(x.y, y.y, false, false); x.y = r1[0]; y.y = r1[1];
}
struct EpiGate8 { struct State {};
    unsigned char* gates;
    __device__ __forceinline__ void operator()(EPI_ARGS) const {
        const int row0 = u.pm * 256 + wr * 64 + fr + (fq & 1) * 16;
#pragma unroll
        for (int bj = 0; bj < 2; ++bj) {
            const int cb = u.pn * 256 + bj * 128 + wc * 32 + 16 * (fq >> 1);
#pragma unroll
            for (int ai = 0; ai < 2; ++ai)
#pragma unroll
                for (int mp = 0; mp < 4; mp += 2) { u32x2 p[2];
                    float g[16];
#pragma unroll
                    for (int h = 0; h < 2; ++h)
#pragma unroll
                        for (int e = 0; e < 4; ++e) { g[8 * h + e] = __builtin_amdgcn_exp2f(acc[ai][bj][mp + h][0][e]); g[8 * h + 4 + e] = __builtin_amdgcn_exp2f(acc[ai][bj][mp + h][1][e]); }
#pragma unroll
                    for (int e = 0; e < 16; ++e) g[e] = fmaf(g[e], 1.0f / 255.0f, 1.0f / 255.0f);
#pragma unroll
                    for (int e = 0; e < 16; ++e) g[e] = __builtin_amdgcn_rcpf(g[e]);
#pragma unroll
                    for (int h = 0; h < 2; ++h) { unsigned w0 = 0u, w1 = 0u;
#pragma unroll
                        for (int e = 0; e < 4; ++e) { w0 = __builtin_amdgcn_cvt_pk_u8_f32(g[8 * h + e], e, w0); w1 = __builtin_amdgcn_cvt_pk_u8_f32(g[8 * h + 4 + e], e, w1); }
                        p[h] = (u32x2){w0, w1}; }
                    swap16_pair(p[0], p[1]);
                    *(u32x4*)(gates + (size_t)(row0 + ai * 128 + mp * 16) * 3072 + cb) = (u32x4){p[0].x, p[0].y, p[1].x, p[1].y}; }
        }
    }
};
struct EpiMerge3H {
    struct State { u32x4 mg[2][4]; u32x4 gp[2][2]; };
    bf16_t* out; const unsigned char* gates;
    __device__ __forceinline__ void prefetch(State& st, const pg8::Unit& u, int wr, int wc, int fr, int fq) const {
        const int row0 = u.pm * 256 + wr * 64 + fr + (fq & 1) * 16, cb = u.pn * 128 + wc * 32 + 16 * (fq >> 1);
#pragma unroll
        for (int ai = 0; ai < 2; ++ai)
#pragma unroll
            for (int mp = 0; mp < 2; ++mp) st.gp[ai][mp] = *(const u32x4*)(gates + (size_t)(row0 + ai * 128 + mp * 32) * 3072 + u.br * 1024 + cb);
    }
    __device__ __forceinline__ void run(const f32x4 (&acc)[2][2][4][2], State& st, const pg8::Unit& u, int wr, int wc, int fr, int fq) const {
        const int row0 = u.pm * 256 + wr * 64 + fr, c8 = u.pn * 128 + wc * 32 + 8 * fq;
#pragma unroll
        for (int ai = 0; ai < 2; ++ai)
#pragma unroll
            for (int m = 0; m < 4; ++m) { u32x2 gx = (u32x2){st.gp[ai][m >> 1].x, st.gp[ai][m >> 1].y}, gy = (u32x2){st.gp[ai][m >> 1].z, st.gp[ai][m >> 1].w};
                swap16_pair(gx, gy); const u32x2 g = (m & 1) ? gy : gx; constexpr float q = 1.0f / 255.0f;
                f32x4 v0 = acc[ai][0][m][0] * q, v1 = acc[ai][0][m][1] * q;
                v0[0] *= (float)((g.x >> 0) & 0xffu); v0[1] *= (float)((g.x >> 8) & 0xffu); v0[2] *= (float)((g.x >> 16) & 0xffu); v0[3] *= (float)((g.x >> 24) & 0xffu);
                v1[0] *= (float)((g.y >> 0) & 0xffu); v1[1] *= (float)((g.y >> 8) & 0xffu); v1[2] *= (float)((g.y >> 16) & 0xffu); v1[3] *= (float)((g.y >> 24) & 0xffu);
                if (u.br != 0) { const u32x4 p = st.mg[ai][m];
                    v0[0] += bflo(p.x); v0[1] += bfhi(p.x); v0[2] += bflo(p.y); v0[3] += bfhi(p.y);
                    v1[0] += bflo(p.z); v1[1] += bfhi(p.z); v1[2] += bflo(p.w); v1[3] += bfhi(p.w); }
                const u32x4 w = pack8(v0, v1);
                if (u.br == 2) *(u32x4*)(out + (size_t)(row0 + ai * 128 + m * 16) * 1024 + c8) = w; else st.mg[ai][m] = w; }
    }
};
struct EpiG6 { struct State {};
    bf16_t* hs; float* logits; float* logits2; int mrows;
    __device__ __forceinline__ void operator()(EPI_ARGS) const {
        const int row0 = u.pm * 256 + wr * 64 + fr;
        if (u.pn < 2) {
            const int dc = u.pn * 128 + wc * 32 + 8 * fq;
#pragma unroll
            for (int ai = 0; ai < 2; ++ai)
#pragma unroll
                for (int mp = 0; mp < 4; mp += 2) { float sg[16];
#pragma unroll
                    for (int h = 0; h < 2; ++h)
#pragma unroll
                        for (int e = 0; e < 4; ++e) { sg[8 * h + e] = __builtin_amdgcn_exp2f(acc[ai][0][mp + h][0][e] * -LOG2E); sg[8 * h + 4 + e] = __builtin_amdgcn_exp2f(acc[ai][0][mp + h][1][e] * -LOG2E); }
#pragma unroll
                    for (int e = 0; e < 16; ++e) sg[e] = 1.0f + sg[e];
#pragma unroll
                    for (int e = 0; e < 16; ++e) sg[e] = __builtin_amdgcn_rcpf(sg[e]);
#pragma unroll
                    for (int h = 0; h < 2; ++h) { const int row = row0 + ai * 128 + (mp + h) * 16; f32x4 v0, v1;
#pragma unroll
                        for (int e = 0; e < 4; ++e) { v0[e] = acc[ai][0][mp + h][0][e] * sg[8 * h + e] * acc[ai][1][mp + h][0][e]; v1[e] = acc[ai][0][mp + h][1][e] * sg[8 * h + 4 + e] * acc[ai][1][mp + h][1][e]; }
                        *(u32x4*)(hs + (size_t)row * 256 + dc) = pack8(v0, v1); } }
        } else {
            const int dc = (wc & 1) * 32 + 8 * fq; float* lg = (wc < 2) ? logits : logits2;
#pragma unroll
            for (int ai = 0; ai < 2; ++ai)
#pragma unroll
                for (int m = 0; m < 4; ++m) { const int row = row0 + ai * 128 + m * 16;
                    float* lp = lg + (size_t)row * 64 + dc;
                    *(f32x4*)lp = acc[ai][0][m][0]; *(f32x4*)(lp + 4) = acc[ai][0][m][1]; }
        }
    }
};
typedef float f32x2v __attribute__((ext_vector_type(2)));
constexpr float Y8_SCALE = 16.0f;
constexpr float F8_SCALE = 8.0f, W8_SCALE = 128.0f, H8_SCALE = 32.0f;
struct EpiG7 { struct State {};
    unsigned char* hmid; const float* pwt; const LAS int* tile_base; const LAS int* tile_nv;
    __device__ __forceinline__ void operator()(EPI_ARGS) const {
        const int rl0 = wr * 64 + fr; const int tbase = tile_base[u.pm], nv = tile_nv[u.pm];
        const int cb = u.pn * 128 + wc * 32 + 16 * (fq >> 1);
#pragma unroll
        for (int ai = 0; ai < 2; ++ai)
#pragma unroll
            for (int mp = 0; mp < 4; mp += 2) { u32x2 p[2];
                float wr2[2];
#pragma unroll
                for (int h = 0; h < 2; ++h) { const int rl = rl0 + ai * 128 + (mp + h) * 16; wr2[h] = (rl < nv ? pwt[tbase + rl] : 0.f) * H8_SCALE; }
                float sg[16];
#pragma unroll
                for (int h = 0; h < 2; ++h)
#pragma unroll
                    for (int e = 0; e < 4; ++e) { sg[8 * h + e] = __builtin_amdgcn_exp2f(acc[ai][0][mp + h][0][e] * -LOG2E); sg[8 * h + 4 + e] = __builtin_amdgcn_exp2f(acc[ai][0][mp + h][1][e] * -LOG2E); }
#pragma unroll
                for (int e = 0; e < 16; ++e) sg[e] = 1.0f + sg[e];
#pragma unroll
                for (int e = 0; e < 16; ++e) sg[e] = __builtin_amdgcn_rcpf(sg[e]);
#pragma unroll
                for (int h = 0; h < 2; ++h) { f32x4 v0, v1;
#pragma unroll
                    for (int e = 0; e < 4; ++e) { v0[e] = acc[ai][0][mp + h][0][e] * sg[8 * h + e] * acc[ai][1][mp + h][0][e] * wr2[h]; v1[e] = acc[ai][0][mp + h][1][e] * sg[8 * h + 4 + e] * acc[ai][1][mp + h][1][e] * wr2[h]; }
                    p[h] = (u32x2){fp8x4(v0[0], v0[1], v0[2], v0[3]), fp8x4(v1[0], v1[1], v1[2], v1[3])}; }
                swap16_pair(p[0], p[1]);
                const int row = u.pm * 256 + rl0 + ai * 128 + (mp + (fq & 1)) * 16;
                *(u32x4*)(hmid + (size_t)row * 256 + cb) = (u32x4){p[0].x, p[0].y, p[1].x, p[1].y}; }
    }
};

struct EpiY8 { struct State {};
    unsigned char* Y; const LAS int* tile_nv;
    __device__ __forceinline__ void operator()(EPI_ARGS) const {
        const int rl0 = wr * 64 + fr + (fq & 1) * 16, row0 = u.pm * 256 + rl0; const int nv = tile_nv ? tile_nv[u.pm] : 256;
#pragma unroll
        for (int bj = 0; bj < 2; ++bj) {
            const int cb = u.pn * 256 + bj * 128 + wc * 32 + 16 * (fq >> 1);
#pragma unroll
            for (int ai = 0; ai < 2; ++ai)
#pragma unroll
                for (int mp = 0; mp < 4; mp += 2) { u32x2 p[2];
#pragma unroll
                    for (int h = 0; h < 2; ++h) { const f32x4 v0 = acc[ai][bj][mp + h][0] * Y8_SCALE, v1 = acc[ai][bj][mp + h][1] * Y8_SCALE;
                        p[h] = (u32x2){fp8x4(v0[0], v0[1], v0[2], v0[3]), fp8x4(v1[0], v1[1], v1[2], v1[3])}; }
                    swap16_pair(p[0], p[1]);
                    if (rl0 + ai * 128 + mp * 16 < nv) *(u32x4*)(Y + (size_t)(row0 + ai * 128 + mp * 16) * 1024 + cb) = (u32x4){p[0].x, p[0].y, p[1].x, p[1].y}; }
        }
    }
};

struct AttnSeg { const bf16_t* k; const bf16_t* vt; int ntiles; int kpos0; };
__device__ __forceinline__ float att_max3(float a, float b, float c) { return __builtin_fmaxf(__builtin_fmaxf(a, b), c); }
template <int DQK, bool BAND, bool SINK, bool QROPE, bool QSWA = false>
__device__ __forceinline__ void attn_unit(LAS unsigned char* lds, const bf16_t* qrow0, int qpitch, unsigned char* orow0, int opitch,
                                          AttnSeg s0, AttnSeg s1, int kpitch, int vpitch, int qpos0, float sink2, const float* tabm) {
    constexpr int NS = DQK / 16, KP = DQK * 2 + 16, VP = 136, KBUF = 64 * KP, VBUF = 64 * VP, CPR = DQK / 8, NCH = 64 * CPR;
    const int tid = threadIdx.x, lane = tid & 63, r = lane & 31, hh = lane >> 5;
    LAS unsigned char* Kb = lds; LAS unsigned char* Vb = lds + 2 * KBUF;
    bf16x8 qf[NS];
#pragma unroll
    for (int s = 0; s < NS; ++s) qf[s] = *(const bf16x8*)(qrow0 + (size_t)r * qpitch + 16 * s + 8 * hh);
    if (QROPE) {
        const int spos = (qpos0 + r) & 4095;
#pragma unroll
        for (int f = 4; f < 6; ++f) { const int pos = (f == 4) ? (spos >> 6) : (spos & 63); const float* cs = tabm + pos * 8; const float* sn = tabm + 512 + pos * 8;
            const u32x4 mine = __builtin_bit_cast(u32x4, qf[f]); u32x4 oth;
#pragma unroll
            for (int q = 0; q < 4; ++q) { auto rr = __builtin_amdgcn_permlane32_swap(mine[q], mine[q], false, false); oth[q] = hh ? rr[0] : rr[1]; }
            float a[8], b[8]; unpack8(mine, a); unpack8(oth, b);
#pragma unroll
            for (int e = 0; e < 8; ++e) a[e] = hh ? (a[e] * cs[e] + b[e] * sn[e]) : (a[e] * cs[e] - b[e] * sn[e]);
            qf[f] = __builtin_bit_cast(bf16x8, packf8(a)); }
    }
    if (QSWA) {
        const int spos = (qpos0 + r) & 4095;
#pragma unroll
        for (int f = 0; f < 4; f += 2) { float a[8], b[8]; unpack8(__builtin_bit_cast(u32x4, qf[f]), a); unpack8(__builtin_bit_cast(u32x4, qf[f + 1]), b);
            if (tabm != nullptr) { const int pos = (f == 0) ? (spos >> 6) : (spos & 63); const float* cs = tabm + pos * 16 + 8 * hh; const float* sn = tabm + 1024 + pos * 16 + 8 * hh;
#pragma unroll
                for (int e = 0; e < 8; ++e) { const float x = a[e] * cs[e] - b[e] * sn[e], y = b[e] * cs[e] + a[e] * sn[e]; a[e] = x; b[e] = y; } }
#pragma unroll
            for (int e = 0; e < 8; ++e) { a[e] *= SWA_QSCALE; b[e] *= SWA_QSCALE; }
            qf[f] = __builtin_bit_cast(bf16x8, packf8(a)); qf[f + 1] = __builtin_bit_cast(bf16x8, packf8(b)); }
    }
    const int ntot = s0.ntiles + s1.ntiles;
    const int kc0 = tid, kc1 = tid + 512;
    const int kr0 = kc0 / CPR, kq0 = kc0 % CPR, kr1 = kc1 / CPR, kq1 = kc1 % CPR;
    const bool k1ok = kc1 < NCH;
    const int vd = tid >> 3, vq = tid & 7;
    u32x4 kA0, kA1 = {0u, 0u, 0u, 0u}, vA, kB0, kB1 = {0u, 0u, 0u, 0u}, vB;
#define ATT_LOAD(it) do { const bool _s1 = (it) >= s0.ntiles; const int _j = _s1 ? (it) - s0.ntiles : (it); const bf16_t* _k = _s1 ? s1.k : s0.k; const bf16_t* _v = _s1 ? s1.vt : s0.vt; \
        kreg0 = *(const u32x4*)(_k + (size_t)(_j * 64 + kr0) * kpitch + kq0 * 8); \
        if (k1ok) kreg1 = *(const u32x4*)(_k + (size_t)(_j * 64 + kr1) * kpitch + kq1 * 8); \
        vreg = *(const u32x4*)(_v + (size_t)vd * vpitch + _j * 64 + vq * 8); } while (0)
#define ATT_STORE(buf) do { *(LAS u32x4*)(Kb + (buf) * KBUF + kr0 * KP + kq0 * 16) = kreg0; \
        if (k1ok) *(LAS u32x4*)(Kb + (buf) * KBUF + kr1 * KP + kq1 * 16) = kreg1; \
        LAS unsigned char* _vp = Vb + (buf) * VBUF + vd * VP + vq * 16; *(LAS u32x2*)_vp = (u32x2){vreg.x, vreg.y}; *(LAS u32x2*)(_vp + 8) = (u32x2){vreg.z, vreg.w}; } while (0)
    f32x16 ot0 = {}, ot1 = {};
#define ATT_KLOAD(kreg0, kreg1, it) do { const bool _s1 = (it) >= s0.ntiles; const int _j = _s1 ? (it) - s0.ntiles : (it); const bf16_t* _k = _s1 ? s1.k : s0.k; \
        kreg0 = *(const u32x4*)(_k + (size_t)(_j * 64 + kr0) * kpitch + kq0 * 8); \
        if (k1ok) kreg1 = *(const u32x4*)(_k + (size_t)(_j * 64 + kr1) * kpitch + kq1 * 8); } while (0)
#define ATT_VLOAD(vreg, it) do { const bool _s1 = (it) >= s0.ntiles; const int _j = _s1 ? (it) - s0.ntiles : (it); const bf16_t* _v = _s1 ? s1.vt : s0.vt; \
        vreg = *(const u32x4*)(_v + (size_t)vd * vpitch + _j * 64 + vq * 8); } while (0)
#define ATT_KSTORE(kreg0, kreg1, buf) do { *(LAS u32x4*)(Kb + (buf) * KBUF + kr0 * KP + kq0 * 16) = kreg0; \
        if (k1ok) *(LAS u32x4*)(Kb + (buf) * KBUF + kr1 * KP + kq1 * 16) = kreg1; } while (0)
#define ATT_VSTORE(vreg, buf) do { LAS unsigned char* _vp = Vb + (buf) * VBUF + vd * VP + vq * 16; *(LAS u32x2*)_vp = (u32x2){vreg.x, vreg.y}; *(LAS u32x2*)(_vp + 8) = (u32x2){vreg.z, vreg.w}; } while (0)
#define ATT_QK(dst0, dst1, buf, cinit) do { const LAS unsigned char* _kp = Kb + (buf) * KBUF + r * KP + hh * 16; \
        _Pragma("unroll") for (int s = 0; s < NS; ++s) { \
            const bf16x8 _k0 = *(const LAS bf16x8*)(_kp + s * 32), _k1 = *(const LAS bf16x8*)(_kp + 32 * KP + s * 32); \
            dst0 = __builtin_amdgcn_mfma_f32_32x32x16_bf16(_k0, qf[s], s == 0 ? cinit : dst0, 0, 0, 0); \
            dst1 = __builtin_amdgcn_mfma_f32_32x32x16_bf16(_k1, qf[s], s == 0 ? cinit : dst1, 0, 0, 0); } } while (0)
#define ATT_ROWMAX(C0, C1, mx) do { float _b; mx = att_max3(C0[0], C0[1], C1[0]); _b = att_max3(C0[2], C0[3], C1[1]); mx = att_max3(mx, C1[2], C1[3]); \
        _Pragma("unroll") for (int i = 4; i < 16; i += 4) { mx = att_max3(mx, C0[i], C0[i + 1]); _b = att_max3(_b, C0[i + 2], C0[i + 3]); mx = att_max3(mx, C1[i], C1[i + 1]); _b = att_max3(_b, C1[i + 2], C1[i + 3]); } \
        mx = fmaxf(mx, _b);     \
        { auto rr = __builtin_amdgcn_permlane32_swap(__float_as_uint(mx), __float_as_uint(mx), false, false); mx = fmaxf(__uint_as_float(rr[0]), __uint_as_float(rr[1])); } } while (0)
    ATT_KLOAD(kA0, kA1, 0); ATT_VLOAD(vA, 0); ATT_KLOAD(kB0, kB1, 1); ATT_KSTORE(kA0, kA1, 0); ATT_VSTORE(vA, 0); ATT_KSTORE(kB0, kB1, 1);
    ATT_KLOAD(kA0, kA1, 2); ATT_VLOAD(vA, 1);
    ATT_KLOAD(kB0, kB1, 3); ATT_VLOAD(vB, 2);
    __syncthreads();
    f32x16 sa0, sa1, sb0, sb1, ol = {}; const f32x16 negm = {};
    const bf16x8 ones = {0x3F80, 0x3F80, 0x3F80, 0x3F80, 0x3F80, 0x3F80, 0x3F80, 0x3F80};
    ATT_QK(sa0, sa1, 0, negm);
    float m_run, d_cur = 0.f;
    { ATT_ROWMAX(sa0, sa1, m_run);
#pragma unroll
      for (int i = 0; i < 16; ++i) { sa0[i] -= m_run; sa1[i] -= m_run; } }
    __syncthreads();
#define SBAR() __builtin_amdgcn_sched_barrier(0)
#define ATT_RM(C0, C1, i) do { if ((i) == 0) mx = att_max3(C0[0], C0[1], C1[0]); else if ((i) == 1) mb = att_max3(C0[2], C0[3], C1[1]); else if ((i) == 2) mx = att_max3(mx, C1[2], C1[3]); \
        else if ((i) < 15) { constexpr int _dummy = 0; const int _q = ((i) - 3) >> 2, _w = ((i) - 3) & 3, _b4 = 4 + 4 * _q; (void)_dummy; \
            if (_w == 0) mx = att_max3(mx, C0[_b4], C0[_b4 + 1]); else if (_w == 1) mb = att_max3(mb, C0[_b4 + 2], C0[_b4 + 3]); \
            else if (_w == 2) mx = att_max3(mx, C1[_b4], C1[_b4 + 1]); else mb = att_max3(mb, C1[_b4 + 2], C1[_b4 + 3]); } } while (0)
#define ATT_EXP4(C0, C1, g, h) do { _Pragma("unroll") for (int e = 0; e < 4; ++e) { if (((g) >> 1) == 0) C0[8 * ((g) & 1) + 4 * (h) + e] = __builtin_amdgcn_exp2f(C0[8 * ((g) & 1) + 4 * (h) + e]); \
        else C1[8 * ((g) & 1) + 4 * (h) + e] = __builtin_amdgcn_exp2f(C1[8 * ((g) & 1) + 4 * (h) + e]); } } while (0)
#define ATT_CVT4(C0, C1, g) do { const int _o = 8 * ((g) & 1); if (((g) >> 1) == 0) { pw[g].x = cvtpk(C0[_o + 0], C0[_o + 1]); pw[g].y = cvtpk(C0[_o + 2], C0[_o + 3]); pw[g].z = cvtpk(C0[_o + 4], C0[_o + 5]); pw[g].w = cvtpk(C0[_o + 6], C0[_o + 7]); } \
        else { pw[g].x = cvtpk(C1[_o + 0], C1[_o + 1]); pw[g].y = cvtpk(C1[_o + 2], C1[_o + 3]); pw[g].z = cvtpk(C1[_o + 4], C1[_o + 5]); pw[g].w = cvtpk(C1[_o + 6], C1[_o + 7]); } } while (0)
#define ATT_VFRAG(dst0_, dst1_, vp_, g) do { const int _ko = 32 * (g); \
        const s16x4 _a0l = *(const LAS s16x4*)((vp_) + _ko), _a0h = *(const LAS s16x4*)((vp_) + _ko + 16); \
        const s16x4 _a1l = *(const LAS s16x4*)((vp_) + 32 * VP + _ko), _a1h = *(const LAS s16x4*)((vp_) + 32 * VP + _ko + 16); \
        dst0_ = (bf16x8){_a0l[0], _a0l[1], _a0l[2], _a0l[3], _a0h[0], _a0h[1], _a0h[2], _a0h[3]}; \
        dst1_ = (bf16x8){_a1l[0], _a1l[1], _a1l[2], _a1l[3], _a1h[0], _a1h[1], _a1h[2], _a1h[3]}; } while (0)
#define ATT_STEP(C0, C1, N0, N1, it, buf, kr0_, kr1_, vr_) do { \
        const bool hasn = (it) + 1 < ntot; \
        if (BAND) { if ((it) >= s0.ntiles) { const int _kb = s1.kpos0 + ((it) - s0.ntiles) * 64 + 4 * hh - (qpos0 + r); \
            _Pragma("unroll") for (int i = 0; i < 16; ++i) { const int d0 = _kb + (i & 3) + 8 * (i >> 2), d1 = d0 + 32; \
                if (d0 > 128 || d0 < -128) C0[i] = -INFINITY; if (d1 > 128 || d1 < -128) C1[i] = -INFINITY; } } } \
        float mx = 0.f, mb = 0.f; \
        if (hasn) { const LAS unsigned char* _kp = Kb + ((buf) ^ 1) * KBUF + r * KP + hh * 16; const float _cv = -m_run; \
            _Pragma("unroll") for (int i = 0; i < 16; ++i) { N0[i] = _cv; N1[i] = _cv; } \
            bf16x8 _ka = *(const LAS bf16x8*)(_kp), _kb2 = *(const LAS bf16x8*)(_kp + 32 * KP); \
              \
            if ((it) + 2 < ntot) ATT_KSTORE(kr0_, kr1_, buf); ATT_VSTORE(vr_, (buf) ^ 1); \
            if ((it) + 4 < ntot) ATT_KLOAD(kr0_, kr1_, (it) + 4); if ((it) + 3 < ntot) ATT_VLOAD(vr_, (it) + 3); SBAR(); \
            _Pragma("unroll") for (int s = 0; s < NS; ++s) { bf16x8 _na = _ka, _nb = _kb2; \
                if (s + 1 < NS) { _na = *(const LAS bf16x8*)(_kp + (s + 1) * 32); _nb = *(const LAS bf16x8*)(_kp + 32 * KP + (s + 1) * 32); } \
                N0 = __builtin_amdgcn_mfma_f32_32x32x16_bf16(_ka, qf[s], N0, 0, 0, 0); ATT_RM(C0, C1, 3 * s); ATT_RM(C0, C1, 3 * s + 1); asm volatile("" : "+v"(mx), "+v"(mb)); SBAR(); \
                N1 = __builtin_amdgcn_mfma_f32_32x32x16_bf16(_kb2, qf[s], N1, 0, 0, 0); ATT_RM(C0, C1, 3 * s + 2); asm volatile("" : "+v"(mx), "+v"(mb)); SBAR(); \
                _ka = _na; _kb2 = _nb; } \
            _Pragma("unroll") for (int i = 3 * NS; i < 15; ++i) ATT_RM(C0, C1, i); \
        } else { _Pragma("unroll") for (int i = 0; i < 15; ++i) ATT_RM(C0, C1, i); } \
        mx = fmaxf(mx, mb); \
        { auto rr = __builtin_amdgcn_permlane32_swap(__float_as_uint(mx), __float_as_uint(mx), false, false); mx = fmaxf(__uint_as_float(rr[0]), __uint_as_float(rr[1])); } \
        float d_nxt = 0.f; \
        if (__any(mx > d_cur)) { const float dl = fmaxf(mx - d_cur, 0.f); const float alpha = __builtin_amdgcn_exp2f(-dl); m_run += dl; d_cur += dl; d_nxt = dl; \
            _Pragma("unroll") for (int i = 0; i < 16; ++i) { ot0[i] *= alpha; ot1[i] *= alpha; ol[i] *= alpha; } } \
        if (__any(d_cur != 0.f)) { _Pragma("unroll") for (int i = 0; i < 16; ++i) { C0[i] -= d_cur; C1[i] -= d_cur; } } \
        d_cur = d_nxt; \
        { const LAS unsigned char* _vp = Vb + (buf) * VBUF + r * VP + hh * 8; u32x4 pw[4]; bf16x8 _a0, _a1; \
          ATT_VFRAG(_a0, _a1, _vp, 0); ATT_EXP4(C0, C1, 0, 0); ATT_EXP4(C0, C1, 0, 1); ATT_CVT4(C0, C1, 0); SBAR(); \
          _Pragma("unroll") for (int g = 0; g < 4; ++g) { bf16x8 _n0 = _a0, _n1 = _a1; const bf16x8 pb = __builtin_bit_cast(bf16x8, pw[g]); \
            if (g + 1 < 4) ATT_VFRAG(_n0, _n1, _vp, g + 1); \
            ot0 = __builtin_amdgcn_mfma_f32_32x32x16_bf16(_a0, pb, ot0, 0, 0, 0); if (g + 1 < 4) ATT_EXP4(C0, C1, g + 1, 0); SBAR(); \
            ot1 = __builtin_amdgcn_mfma_f32_32x32x16_bf16(_a1, pb, ot1, 0, 0, 0); if (g + 1 < 4) ATT_EXP4(C0, C1, g + 1, 1); SBAR(); \
            ol = __builtin_amdgcn_mfma_f32_32x32x16_bf16(ones, pb, ol, 0, 0, 0); if (g + 1 < 4) ATT_CVT4(C0, C1, g + 1); SBAR(); \
            _a0 = _n0; _a1 = _n1; } } \
        __syncthreads(); } while (0)
    for (int it = 0; it < ntot; it += 2) {
        ATT_STEP(sa0, sa1, sb0, sb1, it, 0, kA0, kA1, vA);
        ATT_STEP(sb0, sb1, sa0, sa1, it + 1, 1, kB0, kB1, vB);
    }
#undef ATT_STEP
#undef ATT_RM
#undef ATT_EXP4
#undef ATT_CVT4
#undef ATT_VFRAG
#undef SBAR
#undef ATT_ROWMAX
#undef ATT_KLOAD
#undef ATT_VLOAD
#undef ATT_KSTORE
#undef ATT_VSTORE
#undef ATT_QK
#undef ATT_LOAD
#undef ATT_STORE
    float l_run = ol[0];
    if (SINK) { const float mnew = fmaxf(m_run, sink2); const float alpha = __builtin_amdgcn_exp2f(m_run - mnew);
        l_run = l_run * alpha + __builtin_amdgcn_exp2f(sink2 - mnew);
#pragma unroll
        for (int i = 0; i < 16; ++i) { ot0[i] *= alpha; ot1[i] *= alpha; } }
    const float inv = A8_SCALE / l_run;
    unsigned char* op = orow0 + (size_t)r * opitch + 4 * hh;
#pragma unroll
    for (int g = 0; g < 4; ++g) {
        *(unsigned*)(op + 8 * g) = fp8x4(ot0[4 * g] * inv, ot0[4 * g + 1] * inv, ot0[4 * g + 2] * inv, ot0[4 * g + 3] * inv);
        *(unsigned*)(op + 32 + 8 * g) = fp8x4(ot1[4 * g] * inv, ot1[4 * g + 1] * inv, ot1[4 * g + 2] * inv, ot1[4 * g + 3] * inv);
    }
}

struct Params {
    const float* in[29];
    float* out; unsigned char* ws;
    int ph_lo, ph_hi, use_bar, pad;
};
enum { I_X = 0, I_C, I_CTX, I_CCTX, I_WMOD, I_BMOD, I_GMIX, I_GFFN, I_WIN, I_GQ, I_GKV, I_WUQ, I_WUKV, I_WPOOL, I_PSCALE, I_SINK, I_WBRM, I_WBRP, I_WBRS, I_WOUT,
       I_WROUTER, I_RBIAS, I_WEG, I_WEU, I_WED, I_WSG, I_WSU, I_WSD, I_GFINAL };
constexpr int LDS_MISC = 131072;
constexpr int LDS_PTRS = LDS_MISC + 16;
constexpr int LDS_SCR = LDS_MISC + 512;
constexpr int LDS_BYTES = 131072 + 16384;
struct Frame {
    LAS unsigned char* lds; int tid, lane, wid, G, bid;
    unsigned char* ws; unsigned char* act;
    __device__ __forceinline__ const float* in(int i) const { const LAS unsigned* q = (const LAS unsigned*)(lds + LDS_PTRS) + 2 * i;
        const unsigned lo = __builtin_amdgcn_readfirstlane(q[0]), hi = __builtin_amdgcn_readfirstlane(q[1]); return (const float*)(const __attribute__((address_space(1))) float*)(((unsigned long long)hi << 32) | lo); }
    __device__ __forceinline__ float* outp() const { return (float*)in(29); }
    __device__ __forceinline__ float* mod(int l, int mr, int chunk) const { return (float*)(ws + WS_MOD) + ((size_t)(l * 5 + mr) * 6 + chunk) * 1024; }
    __device__ __forceinline__ unsigned char* wsm(int l) const { return ws + WS_WSM + (size_t)l * WSM_LAYER; }
};
constexpr int NTHREADS = 512;

struct ConvJob { const float* src; const float* rs; bf16_t* dst; int ldsrc, k0, n0, nvalid, lddst, drow0, lo, f8; float mul; };
__device__ __forceinline__ ConvJob mkjob(const float* src, int ldsrc, int k0, int n0, int nvalid, const float* rs, bf16_t* dst, int lddst, int drow0) {
    ConvJob j; j.src = src; j.rs = rs; j.dst = dst; j.ldsrc = ldsrc; j.k0 = k0; j.n0 = n0; j.nvalid = nvalid; j.lddst = lddst; j.drow0 = drow0; j.lo = 0; j.f8 = 0; j.mul = 1.0f; return j; }
struct ConvRegs { f32x4 v[4][2]; };
__device__ __forceinline__ void conv_load1(const Frame& F, const ConvJob& J, f32x4 (&v)[2]) {
    const int kp = F.tid >> 4, j4 = (F.tid & 15) * 4;
#pragma unroll
    for (int h = 0; h < 2; ++h) { f32x4 x = {0.f, 0.f, 0.f, 0.f};
        if (J.src != nullptr && J.n0 + j4 < J.nvalid) x = __builtin_nontemporal_load((const f32x4*)(J.src + (size_t)(J.k0 + 2 * kp + h) * J.ldsrc + J.n0 + j4));
        v[h] = x; }
}
__device__ __forceinline__ void conv_lds1(const Frame& F, const ConvJob& J, const f32x4 (&v)[2], int q) {
    const int kp = F.tid >> 4, j4 = (F.tid & 15) * 4;
    const float s0 = (J.rs ? J.rs[J.k0 + 2 * kp] : 1.0f) * J.mul, s1 = (J.rs ? J.rs[J.k0 + 2 * kp + 1] : 1.0f) * J.mul;
    LAS unsigned* t = (LAS unsigned*)F.lds + q * 64 * 33 + j4 * 33 + kp;
#pragma unroll
    for (int e = 0; e < 4; ++e) { float a0 = v[0][e] * s0, a1 = v[1][e] * s1;
        if (J.lo) { a0 -= bf2f(f2bf(a0)); a1 -= bf2f(f2bf(a1)); }
        t[e * 33] = J.f8 ? (unsigned)__builtin_amdgcn_cvt_pk_fp8_f32(a0, a1, 0, false) : cvtpk(a0, a1); }
}
__device__ __forceinline__ void conv_store1(const Frame& F, const ConvJob& J, int q) {
    const int j = F.tid >> 3, q8 = F.tid & 7;
    const LAS unsigned* t = (const LAS unsigned*)F.lds + q * 64 * 33 + j * 33 + 4 * q8;
    u32x4 w; w.x = t[0]; w.y = t[1]; w.z = t[2]; w.w = t[3];
    if (J.f8) { u32x2 b; b.x = (w.x & 0xffffu) | (w.y << 16); b.y = (w.z & 0xffffu) | (w.w << 16);
        *(u32x2*)((unsigned char*)J.dst + (size_t)(J.drow0 + j) * J.lddst + J.k0 + 8 * q8) = b; }
    else *(u32x4*)(J.dst + (size_t)(J.drow0 + j) * J.lddst + J.k0 + 8 * q8) = w;
}
__device__ __forceinline__ void conv_load4(const Frame& F, const ConvJob& J0, const ConvJob& J1, const ConvJob& J2, const ConvJob& J3, ConvRegs& R) {
    conv_load1(F, J0, R.v[0]); conv_load1(F, J1, R.v[1]); conv_load1(F, J2, R.v[2]); conv_load1(F, J3, R.v[3]); }
__device__ __forceinline__ void conv_finish4(const Frame& F, const ConvJob& J0, const ConvJob& J1, const ConvJob& J2, const ConvJob& J3, const ConvRegs& R) {
    conv_lds1(F, J0, R.v[0], 0); conv_lds1(F, J1, R.v[1], 1); conv_lds1(F, J2, R.v[2], 2); conv_lds1(F, J3, R.v[3], 3);
    __syncthreads();
    conv_store1(F, J0, 0); conv_store1(F, J1, 1); conv_store1(F, J2, 2); conv_store1(F, J3, 3);
    __syncthreads();
}
constexpr int CT_IN = 0, CT_G8 = 16 * 48, CT_I8 = 16 * 32, CT_UQ = 6 * 12, CT_UKV = 4 * 16, CT_BR = 8 * 16, CT_OUT = 16 * 16, CT_RS = 16 * 12, CT_SD = 4 * 16;
constexpr int CT_SMALL = CT_IN + CT_G8 + CT_I8 + CT_UQ + CT_UKV + 2 * CT_BR + CT_OUT + CT_RS + CT_SD;
static_assert(CT_SMALL % 4 == 0, "conversion jobs are taken four at a time");
__device__ __forceinline__ ConvJob conv_small_job(const Frame& F, int l, int id) {
    unsigned char* W = F.wsm(l);
    if (id < CT_IN) { const int kt = id / 32, nt = id % 32;
        return mkjob(F.in(I_WIN) + (size_t)l * 1024 * NIN, NIN, kt * 64, nt * 64, NIN, nullptr, (bf16_t*)(W + WO_IN), 1024, nt * 64); }
    id -= CT_IN;
    if (id < CT_G8) { const int kt = id / 48, j = id % 48;
        ConvJob cj = mkjob(F.in(I_WIN) + (size_t)l * 1024 * NIN, NIN, kt * 64, OFF_GL + 64 * j, NIN, nullptr, (bf16_t*)(W + WO_G8), 1024, 64 * j); cj.f8 = 1; cj.mul = -W8_SCALE * LOG2E; return cj; }
    id -= CT_G8;
    if (id < CT_I8) { const int kt = id / 32, nt = id % 32;
        ConvJob cj = mkjob(F.in(I_WIN) + (size_t)l * 1024 * NIN, NIN, kt * 64, nt * 64, NIN, nullptr, (bf16_t*)(W + WO_I8), 1024, nt * 64); cj.f8 = 1; cj.mul = W8_SCALE; return cj; }
    id -= CT_I8;
    if (id < CT_UQ) { const int kt = id / 12, nt = id % 12;
        ConvJob j = mkjob(F.in(I_WUQ) + (size_t)l * 384 * 768, 768, kt * 64, nt * 64, 768, F.in(I_GQ) + l * 384, (bf16_t*)(W + WO_UQ), 384, nt * 64); j.mul = MLA_QSCALE; return j; }
    id -= CT_UQ;
    if (id < CT_UKV) { const int kt = id / 16, nt = id % 16;
        return mkjob(F.in(I_WUKV) + (size_t)l * 256 * 1024, 1024, kt * 64, nt * 64, 1024, F.in(I_GKV) + l * 256, (bf16_t*)(W + ((nt & 1) ? WO_V : WO_K)), 256, (nt >> 1) * 64); }
    id -= CT_UKV;
    if (id < CT_BR) { const int kt = id / 16, nt = id % 16;
        ConvJob cj = mkjob(F.in(I_WBRM) + (size_t)l * 512 * 1024, 1024, kt * 64, nt * 64, 1024, nullptr, (bf16_t*)(W + WO_BRM), 512, nt * 64); cj.f8 = 1; cj.mul = W8_SCALE; return cj; }
    id -= CT_BR;
    if (id < CT_BR) { const int kt = id / 16, nt = id % 16;
        ConvJob cj = mkjob(F.in(I_WBRS) + (size_t)l * 512 * 1024, 1024, kt * 64, nt * 64, 1024, nullptr, (bf16_t*)(W + WO_BRS), 512, nt * 64); cj.f8 = 1; cj.mul = W8_SCALE; return cj; }
    id -= CT_BR;
    if (id < CT_OUT) { const int kt = id / 16, nt = id % 16;
        return mkjob(F.in(I_WOUT) + (size_t)l * 1024 * 1024, 1024, kt * 64, nt * 64, 1024, nullptr, (bf16_t*)(W + WO_OUT), 1024, nt * 64); }
    id -= CT_OUT;
    if (id < CT_RS) { const int kt = id / 12, rt = id % 12;
        const float* src = nullptr; int ld = 256, n0 = 0;
        if (rt < 8) { const int pn = rt >> 2, isup = (rt >> 1) & 1, sub = rt & 1; src = F.in(isup ? I_WSU : I_WSG) + (size_t)l * 1024 * 256; n0 = pn * 128 + sub * 64; }
        else if (rt == 8 || rt == 9) { src = F.in(I_WROUTER) + (size_t)l * 1024 * 64; ld = 64; n0 = 0; }
        ConvJob j = mkjob(src, ld, kt * 64, n0, ld, nullptr, (bf16_t*)(W + WO_RS), 1024, rt * 64); j.lo = (rt == 9) ? 1 : 0; return j; }
    id -= CT_RS;
    { const int kt = id / 16, nt = id % 16;
      return mkjob(F.in(I_WSD) + (size_t)l * 256 * 1024, 1024, kt * 64, nt * 64, 1024, nullptr, (bf16_t*)(W + WO_SD), 256, nt * 64); }
}
constexpr int CT_EXP = NEXP * 192;
__device__ __forceinline__ ConvJob conv_exp_job(const Frame& F, int l, int id) {
    const int e = id / 192, j = id % 192;
    if (j < 128) { const int isup = j >> 6, jj = j & 63, kt = jj >> 2, m = jj & 3;
        const float* src = F.in(isup ? I_WEU : I_WEG) + ((size_t)l * NEXP + e) * 1024 * 256;
        ConvJob cj = mkjob(src, 256, kt * 64, m * 64, 256, nullptr, (bf16_t*)(F.ws + WS_WGU + (size_t)e * 512 * 1024), 1024, (m >> 1) * 256 + isup * 128 + (m & 1) * 64);
        cj.f8 = 1; cj.mul = W8_SCALE; return cj;
    } else { const int jj = j - 128, kt = jj >> 4, nt = jj & 15;
        const float* src = F.in(I_WED) + ((size_t)l * NEXP + e) * 256 * 1024;
        ConvJob cj = mkjob(src, 1024, kt * 64, nt * 64, 1024, nullptr, (bf16_t*)(F.ws + WS_WDN + (size_t)e * 1024 * 256), 256, nt * 64);
        cj.f8 = 1; cj.mul = W8_SCALE; return cj; }
}
#define CONV_PIPE(NGROUPS, JOB, RANK, NWORK) do { int g = (RANK); if (g >= 0 && g < (NGROUPS)) { ConvRegs R; \
        { const int id = 4 * g; conv_load4(F, JOB(id), JOB(id + 1), JOB(id + 2), JOB(id + 3), R); } \
        for (;;) { const int gn = g + (NWORK); const bool more = gn < (NGROUPS); ConvRegs Rn; \
            if (more) { const int idn = 4 * gn; conv_load4(F, JOB(idn), JOB(idn + 1), JOB(idn + 2), JOB(idn + 3), Rn); } \
            { const int id = 4 * g; conv_finish4(F, JOB(id), JOB(id + 1), JOB(id + 2), JOB(id + 3), R); } \
            if (!more) break; R = Rn; g = gn; } } } while (0)
__device__ __forceinline__ void conv_small_all(const Frame& F, int l, int rank, int nwork) {
#define JOB_SMALL(id) conv_small_job(F, l, (id))
    CONV_PIPE(CT_SMALL / 4, JOB_SMALL, rank, nwork);
#undef JOB_SMALL
}
__device__ __forceinline__ void conv_exp_all(const Frame& F, int l, int rank, int nwork) {
#define JOB_EXP(id) conv_exp_job(F, l, (id))
    CONV_PIPE(CT_EXP / 4, JOB_EXP, rank, nwork);
#undef JOB_EXP
}
__device__ __forceinline__ void wcomb_job(const Frame& F, int l, int id) {
    const int j = id >> 4, n0 = (id & 15) * 64, tid = F.tid;
    LAS float* Pm = (LAS float*)F.lds;
    LAS float* Bm = Pm + 128 * 128;
    const float* wp = F.in(I_WPOOL) + ((size_t)l * 4 + j) * 128 * 128;
    const float* ps = F.in(I_PSCALE) + l * 512 + j * 128;
    const float* wb = F.in(I_WBRP) + ((size_t)l * 512 + j * 128) * 1024;
    for (int i = tid; i < 128 * 128; i += NTHREADS) Pm[i] = wp[i] * ps[i & 127];
    for (int i = tid; i < 128 * 64; i += NTHREADS) Bm[i] = wb[(size_t)(i >> 6) * 1024 + n0 + (i & 63)];
    __syncthreads();
    const int n = tid & 63, cg = tid >> 6;
    float a[16];
#pragma unroll
    for (int e = 0; e < 16; ++e) a[e] = 0.f;
    for (int d = 0; d < 128; d += 4) {
        const float b0 = Bm[d * 64 + n], b1 = Bm[(d + 1) * 64 + n], b2 = Bm[(d + 2) * 64 + n], b3 = Bm[(d + 3) * 64 + n];
#pragma unroll
        for (int e = 0; e < 16; ++e) { const f32x4 p = *(const LAS f32x4*)(Pm + (cg * 16 + e) * 128 + d);
            a[e] = fmaf(p[0], b0, a[e]); a[e] = fmaf(p[1], b1, a[e]); a[e] = fmaf(p[2], b2, a[e]); a[e] = fmaf(p[3], b3, a[e]); } }
    unsigned char* dst = F.wsm(l) + WO_COMB + (size_t)(n0 + n) * 512 + j * 128 + cg * 16;
#pragma unroll
    for (int e = 0; e < 16; ++e) a[e] *= W8_SCALE;
    *(u32x4*)dst = (u32x4){fp8x4(a[0], a[1], a[2], a[3]), fp8x4(a[4], a[5], a[6], a[7]), fp8x4(a[8], a[9], a[10], a[11]), fp8x4(a[12], a[13], a[14], a[15])};
    __syncthreads();
}
__device__ __forceinline__ void mod_job(const Frame& F, int id) {
    const int l = id / 96, n0 = (id % 96) * 64, tid = F.tid, n4 = tid & 15, kq = tid >> 4;
    const float* wm = F.in(I_WMOD) + (size_t)l * 1024 * 6144 + n0 + 4 * n4;
    LAS float* S = (LAS float*)F.lds;
    LAS float* R = S + 5 * 1024;
    for (int i = tid; i < 5 * 1024; i += NTHREADS) { const int r = i >> 10, k = i & 1023; const float cv = (r < 4) ? F.in(I_C)[r * 1024 + k] : F.in(I_CCTX)[k]; S[i] = cv * fast_sigmoid(cv); }
    __syncthreads();
    f32x4 a[5];
#pragma unroll
    for (int r = 0; r < 5; ++r) a[r] = (f32x4){0.f, 0.f, 0.f, 0.f};
    for (int kb = kq * 32; kb < kq * 32 + 32; kb += 16) {
        f32x4 w[16];
#pragma unroll
        for (int u = 0; u < 16; ++u) w[u] = __builtin_nontemporal_load((const f32x4*)(wm + (size_t)(kb + u) * 6144));
#pragma unroll
        for (int u = 0; u < 16; ++u) {
#pragma unroll
            for (int r = 0; r < 5; ++r) a[r] += w[u] * S[r * 1024 + kb + u]; }
    }
#pragma unroll
    for (int r = 0; r < 5; ++r) *(LAS f32x4*)(R + (kq * 5 + r) * 64 + 4 * n4) = a[r];
    __syncthreads();
    if (tid < 320) { const int r = tid >> 6, n = tid & 63; float sacc = 0.f;
#pragma unroll
        for (int g = 0; g < 32; ++g) sacc += R[(g * 5 + r) * 64 + n];
        const int col = n0 + n;
        ((float*)(F.ws + WS_MOD))[(size_t)(l * 5 + r) * 6144 + col] = sacc + F.in(I_BMOD)[l * 6144 + col]; }
    __syncthreads();
}
__device__ __forceinline__ void tab_job(const Frame& F) {
    float* tm = (float*)(F.ws + WS_TABM); float* ts = (float*)(F.ws + WS_TABS);
    for (int i = F.tid; i < 64 * 8 + 64 * 16; i += NTHREADS) {
        const bool mla = i < 512; const int ii = mla ? i : i - 512, nf = mla ? 8 : 16, pos = ii / nf, fi = ii % nf;
        const float invf = exp2f(-(float)fi / (float)nf * 13.287712379549449f);
        float s, c; sincos_small((float)pos * invf, s, c);
        float* tb = mla ? tm : ts; tb[pos * nf + fi] = c; tb[64 * nf + pos * nf + fi] = s;
    }
}
constexpr int P0_MOD = 192, P0_TAB = 1, P0_WCOMB = 2 * 64;
constexpr int P0_ITEMS = P0_MOD + P0_TAB + P0_WCOMB;
__device__ __forceinline__ void setup_layer(const Frame& F, int l, int rank, int nwork) {
    if (rank < 0) return;
    constexpr int NIT = P0_MOD / 2 + P0_WCOMB / 2 + 1;
    for (int it = nwork - 1 - rank; it < NIT; it += nwork) {
        int id = it;
        if (id < P0_MOD / 2) { mod_job(F, l * (P0_MOD / 2) + id); continue; } id -= P0_MOD / 2;
        if (id < P0_WCOMB / 2) { wcomb_job(F, l, id); continue; }
        if (l == 0) tab_job(F);
    }
    conv_small_all(F, l, rank, nwork);
}
__device__ __forceinline__ void phase_p0(const Frame& F) { setup_layer(F, 0, F.bid, F.G); }

struct RouteTabs { const LAS int* off; const LAS int* tile_e; const LAS int* tile_base; const LAS int* tile_nv; int ntiles; };
__device__ __forceinline__ RouteTabs route_tables(const Frame& F, int l, bool tiles) {
    LAS int* cn = (LAS int*)(F.lds + LDS_SCR); LAS int* off = cn + 64; LAS int* te = cn + 192; LAS int* tb = te + MAXTILES; LAS int* tn = tb + MAXTILES;
    const unsigned* cnt = (const unsigned*)(F.ws + WS_CTL) + CW_CNT + l * 64;
    __syncthreads();
    if (F.tid < 64) cn[F.tid] = (int)ld_ctl(cnt + F.tid);
    __syncthreads();
    if (F.tid == 0) { int o = 0; for (int e = 0; e < 64; ++e) { off[e] = o; o += (cn[e] + 255) & ~255; } off[64] = o; }
    __syncthreads();
    RouteTabs r; r.off = off; r.tile_e = te; r.tile_base = tb; r.tile_nv = tn; r.ntiles = off[64] >> 8;
    if (tiles) { for (int tl = F.tid; tl < r.ntiles; tl += NTHREADS) { int e = 0; for (int q = 1; q < 64; ++q) e += (off[q] <= tl * 256) ? 1 : 0;
                     const int first = tl * 256 - off[e]; te[tl] = e; tb[tl] = e * TT + first; tn[tl] = cn[e] - first; }
                 __syncthreads(); }
    return r;
}

__device__ __forceinline__ const float* xin_row(const Frame& F, int l, int t) {
    (void)l;
    return t < TL ? F.in(I_X) + (size_t)t * 1024 : F.in(I_CTX) + (size_t)(t - TL) * 1024;
}
__device__ __forceinline__ unsigned dpp_xor1(unsigned x) { return (unsigned)__builtin_amdgcn_update_dpp(0, (int)x, 0xB1, 0xF, 0xF, true); }
__device__ __forceinline__ void store_pair_b16(bf16_t* row, int i0, int i1, const u32x2& w0, const u32x2& w1, int lane) {
    const bool odd = lane & 1; const u32x2 snd = odd ? w0 : w1; const u32x2 rcv = (u32x2){dpp_xor1(snd.x), dpp_xor1(snd.y)};
    const u32x4 o = odd ? (u32x4){rcv.x, rcv.y, w1.x, w1.y} : (u32x4){w0.x, w0.y, rcv.x, rcv.y};
    *(u32x4*)(row + 256 * (odd ? i1 : i0) + 4 * (lane & ~1)) = o; }
__device__ __forceinline__ void store_pair_b8(unsigned char* row, int i0, int i1, unsigned w0, unsigned w1, int lane) {
    const bool odd = lane & 1; const unsigned rcv = dpp_xor1(odd ? w0 : w1);
    const u32x2 o = odd ? (u32x2){rcv, w1} : (u32x2){w0, rcv};
    *(u32x2*)(row + 256 * (odd ? i1 : i0) + 4 * (lane & ~1)) = o; }
__device__ __forceinline__ void norm_mod_store(const f32x4 (&v)[4], const float* g, const float* sc, const float* sh, bf16_t* dst, int lane, unsigned char* dst8 = nullptr) {
    float ss = 0.f;
#pragma unroll
    for (int i = 0; i < 4; ++i) ss += v[i][0] * v[i][0] + v[i][1] * v[i][1] + v[i][2] * v[i][2] + v[i][3] * v[i][3];
    ss = wave_sum(ss);
    const float rstd = rsqrtf(ss * (1.0f / 1024.0f) + NORM_EPS);
    u32x2 wb[4]; unsigned w8[4];
#pragma unroll
    for (int i = 0; i < 4; ++i) { const int c = 4 * lane + 256 * i;
        const f32x4 gv = *(const f32x4*)(g + c), sv = *(const f32x4*)(sc + c), hv = *(const f32x4*)(sh + c);
        f32x4 o;
#pragma unroll
        for (int e = 0; e < 4; ++e) o[e] = v[i][e] * rstd * gv[e] * (1.0f + sv[e]) + hv[e];
        wb[i].x = cvtpk(o[0], o[1]); wb[i].y = cvtpk(o[2], o[3]);
        { int q = 0; q = __builtin_amdgcn_cvt_pk_fp8_f32(o[0] * F8_SCALE, o[1] * F8_SCALE, q, false); q = __builtin_amdgcn_cvt_pk_fp8_f32(o[2] * F8_SCALE, o[3] * F8_SCALE, q, true); w8[i] = (unsigned)q; } }
    if (dst)  { store_pair_b16(dst, 0, 1, wb[0], wb[1], lane); store_pair_b16(dst, 2, 3, wb[2], wb[3], lane); }
    if (dst8) { store_pair_b8(dst8, 0, 1, w8[0], w8[1], lane); store_pair_b8(dst8, 2, 3, w8[2], w8[3], lane); }
}
__device__ __forceinline__ void phase_e1(const Frame& F) {
    const float* g = F.in(I_GMIX);
    for (int t = F.bid * 8 + F.wid; t < TT; t += F.G * 8) {
        const float* xr = xin_row(F, 0, t); f32x4 v[4];
#pragma unroll
        for (int i = 0; i < 4; ++i) v[i] = __builtin_nontemporal_load((const f32x4*)(xr + 4 * F.lane + 256 * i));
        const int mr = tok_modrow(t);
        norm_mod_store(v, g, F.mod(0, mr, 1), F.mod(0, mr, 0), nullptr, F.lane, F.ws + WS_H8 + (size_t)t * 1024);
    }
}
__device__ __forceinline__ void phase_e5(const Frame& F, int l, int Te) {
    const float* g = F.in(I_GFFN) + l * 1024;
    bf16_t* Fb = (bf16_t*)(F.act + A_F);
    unsigned char* F8 = F.act + A_F8;
    if (F.bid == 0) { for (int i = F.tid; i < 512; i += NTHREADS) ((unsigned*)(Fb + (size_t)TT * 1024))[i] = 0u;
        for (int i = F.tid; i < 256; i += NTHREADS) ((unsigned*)(F8 + (size_t)TT * 1024))[i] = 0u; }
    for (int t = F.bid * 8 + F.wid; t < Te; t += F.G * 8) {
        const int mr = tok_modrow(t); const bf16_t* xr = (const bf16_t*)(F.ws + WS_X) + (size_t)t * 1024; f32x4 v[4];
#pragma unroll
        for (int i = 0; i < 4; ++i) { const u32x2 xw = *(const u32x2*)(xr + 4 * F.lane + 256 * i); v[i] = (f32x4){bflo(xw.x), bfhi(xw.x), bflo(xw.y), bfhi(xw.y)}; }
        norm_mod_store(v, g, F.mod(l, mr, 4), F.mod(l, mr, 3), Fb + (size_t)t * 1024, F.lane, F8 + (size_t)t * 1024);
    }
}
__device__ __forceinline__ void phase_e6(const Frame& F, int l, int Te) {
    const unsigned char* Y = F.act + A_YH0; const unsigned char* YS = F.act + A_YS;
    const int* toke = (const int*)(F.ws + WS_TOKE); const int* tokp = (const int*)(F.ws + WS_TOKP); const RouteTabs rt = route_tables(F, l, false);
    const bool last = (l == DEPTH - 1);
    for (int t = F.bid * 8 + F.wid; t < Te; t += F.G * 8) {
        const int c = 16 * F.lane; const int mr = tok_modrow(t);
        bf16_t* xo = (bf16_t*)(F.ws + WS_X) + (size_t)t * 1024 + c;
        float a[16];
#pragma unroll
        for (int i = 0; i < 16; ++i) a[i] = 0.f;
#pragma unroll
        for (int k = 0; k < 8; ++k) { const int rw = rt.off[toke[t * 8 + k]] + tokp[t * 8 + k]; const u32x4 w = *(const u32x4*)(Y + (size_t)rw * 1024 + c);
#pragma unroll
            for (int q = 0; q < 4; ++q) { const f32x2v lo = __builtin_amdgcn_cvt_pk_f32_fp8((int)w[q], false), hi = __builtin_amdgcn_cvt_pk_f32_fp8((int)w[q], true);
                a[4 * q] += lo.x; a[4 * q + 1] += lo.y; a[4 * q + 2] += hi.x; a[4 * q + 3] += hi.y; } }
        { const u32x4 w = *(const u32x4*)(YS + (size_t)t * 1024 + c);
#pragma unroll
          for (int q = 0; q < 4; ++q) { const f32x2v lo = __builtin_amdgcn_cvt_pk_f32_fp8((int)w[q], false), hi = __builtin_amdgcn_cvt_pk_f32_fp8((int)w[q], true);
              a[4 * q] += lo.x; a[4 * q + 1] += lo.y; a[4 * q + 2] += hi.x; a[4 * q + 3] += hi.y; }
#pragma unroll
          for (int i = 0; i < 16; ++i) a[i] *= (1.0f / Y8_SCALE); }
        const float* gt = F.mod(l, mr, 5) + c;
        float x[16]; float ss = 0.f;
        { float xin[16]; unpack8(*(const u32x4*)xo, *(float(*)[8])&xin[0]); unpack8(*(const u32x4*)(xo + 8), *(float(*)[8])&xin[8]);
#pragma unroll
          for (int q = 0; q < 4; ++q) { const f32x4 gv = *(const f32x4*)(gt + 4 * q);
#pragma unroll
            for (int e = 0; e < 4; ++e) { x[4 * q + e] = xin[4 * q + e] + gv[e] * a[4 * q + e]; ss += x[4 * q + e] * x[4 * q + e]; } } }
        ss = wave_sum(ss);
        const float rstd = rsqrtf(ss * (1.0f / 1024.0f) + NORM_EPS);
        if (last) {
            if (t < TL) { const float* gf = F.in(I_GFINAL) + c; float* o = F.outp() + (size_t)t * 1024 + c;
#pragma unroll
                for (int q = 0; q < 4; ++q) { const f32x4 gv = *(const f32x4*)(gf + 4 * q); f32x4 ov;
#pragma unroll
                    for (int e = 0; e < 4; ++e) ov[e] = x[4 * q + e] * rstd * gv[e];
                    *(f32x4*)(o + 4 * q) = ov; } }
        } else {
            *(u32x4*)xo = packf8(*(const float(*)[8])&x[0]); *(u32x4*)(xo + 8) = packf8(*(const float(*)[8])&x[8]);
            const float* g = F.in(I_GMIX) + (l + 1) * 1024 + c; const float* sc = F.mod(l + 1, mr, 1) + c; const float* sh = F.mod(l + 1, mr, 0) + c;
            float o[16];
#pragma unroll
            for (int q = 0; q < 4; ++q) { const f32x4 gv = *(const f32x4*)(g + 4 * q), sv = *(const f32x4*)(sc + 4 * q), hv = *(const f32x4*)(sh + 4 * q);
#pragma unroll
                for (int e = 0; e < 4; ++e) o[4 * q + e] = x[4 * q + e] * rstd * gv[e] * (1.0f + sv[e]) + hv[e]; }
            { u32x4 w8;
#pragma unroll
              for (int q = 0; q < 4; ++q) { int w = 0; w = __builtin_amdgcn_cvt_pk_fp8_f32(o[4 * q] * F8_SCALE, o[4 * q + 1] * F8_SCALE, w, false); w = __builtin_amdgcn_cvt_pk_fp8_f32(o[4 * q + 2] * F8_SCALE, o[4 * q + 3] * F8_SCALE, w, true); w8[q] = (unsigned)w; }
              *(u32x4*)(F.ws + WS_H8 + (size_t)t * 1024 + c) = w8; }
        }
    }
}
__device__ __forceinline__ void rope8(float (&mine)[8], const float (&oth)[8], const float* cs, const float* sn, bool first) {
#pragma unroll
    for (int e = 0; e < 8; ++e) mine[e] = first ? (mine[e] * cs[e] - oth[e] * sn[e]) : (mine[e] * cs[e] + oth[e] * sn[e]);
}
__device__ __forceinline__ void phase_e3(const Frame& F) {
    const bf16_t* CQ = (const bf16_t*)(F.act + A_CQ); const bf16_t* CKV = (const bf16_t*)(F.act + A_CKV); const bf16_t* KR = (const bf16_t*)(F.act + A_KR);
    const bf16_t* U = (const bf16_t*)(F.act + A_U); const bf16_t* QSR = (const bf16_t*)(F.act + A_QSR); const bf16_t* KSR = (const bf16_t*)(F.act + A_KSR);
    bf16_t* CQN = (bf16_t*)(F.act + A_CQN); bf16_t* CKVN = (bf16_t*)(F.act + A_CKVN); unsigned char* POOL = F.act + A_POOL;
    bf16_t* QS = (bf16_t*)(F.act + A_QS); bf16_t* KS = (bf16_t*)(F.act + A_KS); bf16_t* KK = (bf16_t*)(F.act + A_K);
    const float* tabm = (const float*)(F.ws + WS_TABM); const float* tabs = (const float*)(F.ws + WS_TABS);
    const int lane = F.lane;
    for (int t = F.bid * 8 + F.wid; t < TT; t += F.G * 8) {
        const bool lat = t < TL; const int s = lat ? (t & 4095) : ((t - TL) & 255); const int L = lat ? SEQ : CTXL;
        const int prow = s >> 6, pcol = s & 63;
        const int kh = (lane & 31) >> 2, kq = lane & 3; const bf16_t* kr = KR + (size_t)t * 32;
        const u32x4 krm = *(const u32x4*)(kr + 8 * kq), kro = *(const u32x4*)(kr + 8 * (kq ^ 1));
        const int w = 2 << (lane >> 4); int lo = s - (w >> 1), hi = s + (w >> 1); lo = lo < 0 ? 0 : lo; hi = hi > L ? L : hi;
        const bf16_t* ub = U + (size_t)(t - s) * 512 + 8 * lane;
        u32x4 uw[16];
#pragma unroll
        for (int k = 0; k < 16; ++k) { const int q = lo + k; uw[k] = *(const u32x4*)(ub + (size_t)(q < hi ? q : s) * 512); }
        const u32x4 ume = *(const u32x4*)(ub + (size_t)s * 512);
        const int kl = lane & 15;
        const u32x4 ka = *(const u32x4*)(KSR + (size_t)t * 128 + 8 * kl), kb = *(const u32x4*)(KSR + (size_t)t * 128 + 8 * (kl ^ 2));
        { float a[8], b[8]; unpack8(krm, a); unpack8(kro, b);
          if (lat) { const int pos = (kq < 2) ? prow : pcol; rope8(a, b, tabm + pos * 8, tabm + 512 + pos * 8, (kq & 1) == 0); }
          if (lane < 32) *(u32x4*)(KK + (size_t)t * 768 + kh * 96 + 64 + 8 * kq) = packf8(a); }
        { float acc[8] = {0.f, 0.f, 0.f, 0.f, 0.f, 0.f, 0.f, 0.f};
#pragma unroll
          for (int k = 0; k < 16; ++k) { float a[8]; unpack8(uw[k], a); const float on = (lo + k < hi) ? 1.0f : 0.0f;
#pragma unroll
              for (int e = 0; e < 8; ++e) acc[e] = fmaf(a[e], on, acc[e]); }
          float me[8]; unpack8(ume, me);
          const float inv = 1.0f / (float)(hi - lo);
#pragma unroll
          for (int e = 0; e < 8; ++e) acc[e] = (acc[e] * inv - me[e]) * A8_SCALE;
          *(u32x2*)(POOL + (size_t)t * 512 + 8 * lane) = (u32x2){fp8x4(acc[0], acc[1], acc[2], acc[3]), fp8x4(acc[4], acc[5], acc[6], acc[7])}; }
        { float a[8], b[8]; unpack8(ka, a); unpack8(kb, b);
          if (lat) { const int qt = (kl & 7) >> 1, i0 = (kl & 1) * 8; const int pos = (qt < 2) ? prow : pcol;
              rope8(a, b, tabs + pos * 16 + i0, tabs + 1024 + pos * 16 + i0, (qt & 1) == 0); }
          if (lane < 16) *(u32x4*)(KS + (size_t)t * 128 + 8 * lane) = packf8(a); }
    }
}
__device__ __forceinline__ void phase_att(const Frame& F, int l) {
    const bool last = (l == DEPTH - 1);
    const bf16_t* Q = (const bf16_t*)(F.act + A_Q); const bf16_t* K = (const bf16_t*)(F.act + A_K); const bf16_t* VT = (const bf16_t*)(F.act + A_VT);
    const bf16_t* QS = (const bf16_t*)(F.act + A_QS); const bf16_t* KS = (const bf16_t*)(F.act + A_KS); const bf16_t* VST = (const bf16_t*)(F.act + A_VST);
    unsigned char* YM = F.act + A_YMLA; unsigned char* YW = F.act + A_YSWA;
    const int wid = F.wid;
    const int nper = F.G / 8;
    for (int v = F.bid / 8; v < 64; v += nper) {
        const int x = F.bid & 7, bh = x * 4 + (v >> 4), qb = v & 15, b = bh >> 3, h = bh & 7;
        const int row0 = b * SEQ + qb * 256 + 32 * wid;
        AttnSeg s0, s1;
        s0.k = K + (size_t)(TL + b * CTXL) * 768 + h * 96; s0.vt = VT + (size_t)(h * 64) * TT + TL + b * CTXL; s0.ntiles = 4; s0.kpos0 = 0;
        s1.k = K + (size_t)(b * SEQ) * 768 + h * 96;       s1.vt = VT + (size_t)(h * 64) * TT + b * SEQ;       s1.ntiles = 64; s1.kpos0 = 0;
        attn_unit<96, false, false, true>(F.lds, Q + (size_t)row0 * 768 + h * 96, 768, YM + (size_t)row0 * 512 + h * 64, 512, s0, s1, 768, TT, qb * 256 + 32 * wid, 0.f, (const float*)(F.ws + WS_TABM));
    }
    for (int u = F.bid; u < 512; u += F.G) {
        const int pair = u & 1, n = (u >> 1) & 31, kvh = (u >> 6) & 1, b = u >> 7;
        const int head = kvh * 4 + pair * 2 + (wid >> 2), tq = n * 128 + 32 * (wid & 3), row0 = b * SEQ + tq;
        const int nb0 = n > 0 ? n - 1 : 0, nb1 = n < 31 ? n + 1 : 31;
        AttnSeg s0, s1;
        s0.k = KS + (size_t)(TL + b * CTXL) * 128 + kvh * 64; s0.vt = VST + (size_t)(kvh * 64) * TT + TL + b * CTXL; s0.ntiles = 4; s0.kpos0 = 0;
        s1.k = KS + (size_t)(b * SEQ + nb0 * 128) * 128 + kvh * 64; s1.vt = VST + (size_t)(kvh * 64) * TT + b * SEQ + nb0 * 128; s1.ntiles = 2 * (nb1 - nb0 + 1); s1.kpos0 = nb0 * 128;
        const float sink2 = F.in(I_SINK)[l * 8 + head] * LOG2E;
        attn_unit<64, true, true, false, true>(F.lds, QS + (size_t)row0 * 512 + head * 64, 512, YW + (size_t)row0 * 512 + head * 64, 512, s0, s1, 128, TT, tq, sink2, (const float*)(F.ws + WS_TABS));
    }
    if (!last) {
        AttnSeg s1; s1.k = nullptr; s1.vt = nullptr; s1.ntiles = 0; s1.kpos0 = 0;
        for (int u = F.bid; u < 32; u += F.G) {
            const int b = u >> 3, h = u & 7, row0 = TL + b * CTXL + 32 * wid;
            AttnSeg s0; s0.k = K + (size_t)(TL + b * CTXL) * 768 + h * 96; s0.vt = VT + (size_t)(h * 64) * TT + TL + b * CTXL; s0.ntiles = 4; s0.kpos0 = 0;
            attn_unit<96, false, false, false>(F.lds, Q + (size_t)row0 * 768 + h * 96, 768, YM + (size_t)row0 * 512 + h * 64, 512, s0, s1, 768, TT, 0, 0.f, nullptr);
        }
        for (int u = F.G - 1 - F.bid; u < 32; u += F.G) {
            const int b = u >> 3, head = u & 7, kvh = head >> 2, row0 = TL + b * CTXL + 32 * wid;
            AttnSeg s0; s0.k = KS + (size_t)(TL + b * CTXL) * 128 + kvh * 64; s0.vt = VST + (size_t)(kvh * 64) * TT + TL + b * CTXL; s0.ntiles = 4; s0.kpos0 = 0;
            const float sink2 = F.in(I_SINK)[l * 8 + head] * LOG2E;
            attn_unit<64, false, true, false, true>(F.lds, QS + (size_t)row0 * 512 + head * 64, 512, YW + (size_t)row0 * 512 + head * 64, 512, s0, s1, 128, TT, 0, sink2, nullptr);
        }
    }
}

__device__ __forceinline__ float rdlane_f(float v, int l) { return __int_as_float(__builtin_amdgcn_readlane(__float_as_int(v), l)); }
__device__ __forceinline__ void phase_r1(const Frame& F, int l, int Te) {
    LAS unsigned char* sb = F.lds + LDS_SCR;
    LAS int* lcount = (LAS int*)sb; LAS int* lbase = lcount + 64; LAS int* se = lbase + 64;
    const int TPB = (Te + F.G - 1) / F.G;
    LAS int* sp = se + 80 * 8; LAS float* sw = (LAS float*)(sp + 80 * 8);
    const float* logits = (const float*)(F.ws + WS_LOGIT); const float* logits2 = (const float*)(F.ws + WS_LOGIT2);
    unsigned* cnt = (unsigned*)(F.ws + WS_CTL) + CW_CNT + l * 64;
    const int lane = F.lane, g = lane >> 3;
    if (F.tid < 64) lcount[F.tid] = 0;
    __syncthreads();
    const int t0 = F.bid * TPB;
    const float bias = F.in(I_RBIAS)[l * 64 + lane];
    for (int ti = F.wid; ti < TPB; ti += 8) {
        const int t = t0 + ti; if (t >= Te) break;
        const float score = 1.0f / (1.0f + expf(-(logits[(size_t)t * 64 + lane] + logits2[(size_t)t * 64 + lane])));
        const float selv = score + bias;
        float m1 = selv; m1 = fmaxf(m1, __shfl_xor(m1, 1)); m1 = fmaxf(m1, __shfl_xor(m1, 2)); m1 = fmaxf(m1, __shfl_xor(m1, 4));
        const unsigned long long eq = __ballot(selv == m1);
        const int first = __builtin_ctz((unsigned)((eq >> (g * 8)) & 0xffull));
        float m2 = ((lane & 7) == first) ? -INFINITY : selv; m2 = fmaxf(m2, __shfl_xor(m2, 1)); m2 = fmaxf(m2, __shfl_xor(m2, 2)); m2 = fmaxf(m2, __shfl_xor(m2, 4));
        const float gs = m1 + m2;
        int grank = 0;
#pragma unroll
        for (int g2 = 0; g2 < 8; ++g2) { const float o = rdlane_f(gs, g2 * 8); grank += (o > gs || (o == gs && g2 < g)) ? 1 : 0; }
        const bool gsel = grank < 4;
        const float ms = gsel ? selv : -INFINITY;
        int rnk = 0;
#pragma unroll
        for (int e2 = 0; e2 < 64; ++e2) { const float o = rdlane_f(ms, e2); rnk += (o > ms || (o == ms && e2 < lane)) ? 1 : 0; }
        const bool chosen = gsel && rnk < 8;
        const float wsum = wave_sum(chosen ? score : 0.f);
        if (chosen) { const int lp = atomicAdd((int*)&lcount[lane], 1);
            se[ti * 8 + rnk] = lane; sp[ti * 8 + rnk] = lp; sw[ti * 8 + rnk] = score / wsum * 2.5f; }
    }
    __syncthreads();
    if (F.tid < 64) lbase[F.tid] = (int)xb_add(cnt + F.tid, (unsigned)lcount[F.tid]);
    __syncthreads();
    int* toke = (int*)(F.ws + WS_TOKE); int* tokp = (int*)(F.ws + WS_TOKP); int* ptok = (int*)(F.ws + WS_PTOK); float* pwt = (float*)(F.ws + WS_PWT);
    for (int i = F.tid; i < TPB * 8; i += NTHREADS) { const int t = t0 + (i >> 3); if (t >= Te) break;
        const int e = se[i], pos = lbase[e] + sp[i]; toke[(size_t)t * 8 + (i & 7)] = e; tokp[(size_t)t * 8 + (i & 7)] = pos;
        ptok[(size_t)e * TT + pos] = t; pwt[(size_t)e * TT + pos] = sw[i]; }
    __syncthreads();
}
__device__ __forceinline__ pg8::Dense dense(const Frame& F, const void* A, const void* Bt, int M, int N, int K, int rot) {
    pg8::Dense d; d.A = (const bf16_t*)A; d.Bt = (const bf16_t*)Bt; d.nM = M / 256; d.nN = N / 256; d.K = K; d.G = F.G; d.c = (F.bid + F.G - (rot % F.G)) % F.G; return d;
}
__device__ __forceinline__ void phase_g1(const Frame& F, int l) {
    unsigned char* W = F.wsm(l);
    { EpiGate8 E; E.gates = F.act + A_GATES;
      pg8::DenseT<true, 0x7A7A7A7A, 0x7A7A7A7A> d; d.A = (const bf16_t*)(F.ws + WS_H8); d.Bt = (const bf16_t*)(W + WO_G8); d.nM = TT / 256; d.nN = 3072 / 256; d.K = 512; d.G = F.G; d.c = F.bid;
      pg8::gemm_phase(F.lds, d, E); }
    { EpiSeg E; E.act = F.act;
      pg8::DenseT<true, 0x7A7A7A7A, 0x7A7A7A7A> d; d.A = (const bf16_t*)(F.ws + WS_H8); d.Bt = (const bf16_t*)(W + WO_I8); d.nM = TT / 256; d.nN = 8; d.K = 512; d.G = F.G; d.c = (F.bid + F.G - 48) % F.G;
      pg8::gemm_phase(F.lds, d, E); }
    { EpiStore E; E.O = (bf16_t*)(F.act + A_VST); E.ldo = TT; E.lgin = 20; E.gout = 0; E.mrows = 256;
      pg8::DenseT<true, 0x7A7A7A7A, 0x7A7A7A7A> d; d.A = (const bf16_t*)(W + WO_I8 + (size_t)OFF_VS * 1024); d.Bt = (const bf16_t*)(F.ws + WS_H8); d.nM = 1; d.nN = TT / 256; d.K = 512; d.G = F.G; d.c = (F.bid + F.G - 80) % F.G;
      pg8::gemm_phase(F.lds, d, E); }
}
__device__ __forceinline__ void phase_g2(const Frame& F, int l) {
    unsigned char* W = F.wsm(l);
    LAS float* tab = (LAS float*)(F.lds + LDS_SCR);
    { EpiStoreRS<384> E; E.O = (bf16_t*)(F.act + A_Q); E.ldo = 768; E.lgin = 20; E.gout = 0; E.src = (const bf16_t*)(F.act + A_CQ); E.tab = tab;
      pg8::gemm_phase(F.lds, dense(F, F.act + A_CQ, W + WO_UQ, TT, 768, 384, 0), E); }
    { EpiStoreRS<256> E; E.O = (bf16_t*)(F.act + A_K); E.ldo = 768; E.lgin = 6; E.gout = 96; E.src = (const bf16_t*)(F.act + A_CKV); E.tab = tab;
      pg8::gemm_phase(F.lds, dense(F, F.act + A_CKV, W + WO_K, TT, 512, 256, 208), E); }
    { EpiStoreCS E; E.O = (bf16_t*)(F.act + A_VT); E.ldo = TT; E.src = (const bf16_t*)(F.act + A_CKV); E.tab = tab;
      pg8::gemm_phase(F.lds, dense(F, W + WO_V, F.act + A_CKV, 512, TT, 256, 88), E); }
}
__device__ __forceinline__ void phase_g4(const Frame& F, int l, int Mr) {
    unsigned char* W = F.wsm(l);
    pg8::Merge3HT<true, 0x79797979, 0x79797979> P;
    P.A0 = (const bf16_t*)(F.act + A_YMLA); P.A1 = (const bf16_t*)(F.act + A_POOL); P.A2 = (const bf16_t*)(F.act + A_YSWA);
    P.B0 = (const bf16_t*)(W + WO_BRM); P.B1 = (const bf16_t*)(W + WO_COMB); P.B2 = (const bf16_t*)(W + WO_BRS); P.nM = Mr / 256; P.nN = 8; P.K = 256; P.G = F.G; P.c = F.bid;
    EpiMerge3H E; E.out = (bf16_t*)(F.act + A_H); E.gates = F.act + A_GATES;
    pg8::gemm_phase(F.lds, P, E);
}
__device__ __forceinline__ void phase_g5(const Frame& F, int l, int Mr) {
    EpiResid E; E.X = (bf16_t*)(F.ws + WS_X); E.xlat = (l == 0) ? F.in(I_X) : nullptr; E.xctx = (l == 0) ? F.in(I_CTX) : nullptr; E.mod2 = F.mod(l, 0, 2);
    const int full = (Mr / 256) * 4 > F.G ? (F.G / 4) : (Mr / 256);
    pg8::gemm_phase(F.lds, dense(F, F.act + A_H, F.wsm(l) + WO_OUT, full * 256, 1024, 1024, 0), E);
    if (full < Mr / 256) { pg8::DenseH d; d.A = (const bf16_t*)(F.act + A_H); d.Bt = (const bf16_t*)(F.wsm(l) + WO_OUT); d.pm0 = full; d.nM = Mr / 256 - full; d.nN = 8; d.K = 1024; d.G = F.G; d.c = F.bid;
        pg8::gemm_phase(F.lds, d, E); }
}
__device__ __forceinline__ void phase_g6(const Frame& F, int l, int Mr) {
    EpiG6 E; E.hs = (bf16_t*)(F.act + A_HS); E.logits = (float*)(F.ws + WS_LOGIT); E.logits2 = (float*)(F.ws + WS_LOGIT2); E.mrows = Mr;
    pg8::gemm_phase(F.lds, dense(F, F.act + A_F, F.wsm(l) + WO_RS, Mr, 768, 1024, 0), E);
}
__device__ __forceinline__ void phase_g7(const Frame& F, int l, int Mr) {
    pg8::Grouped<true, true, 0x7A7A7A7A, 0x7A7A7A7A> P;
    P.A = (const bf16_t*)(F.act + A_F8); P.W = (const bf16_t*)(F.ws + WS_WGU); P.estride = (size_t)512 * 512; P.ncol0 = 0;
    const RouteTabs rt = route_tables(F, l, true); P.ntiles = rt.ntiles; P.tile_e = rt.tile_e; P.tile_base = rt.tile_base; P.tile_nv = rt.tile_nv; P.ptok = (const int*)(F.ws + WS_PTOK); P.nN = 2; P.K = 512; P.G = F.G; P.c = F.bid;
    EpiG7 E; E.hmid = F.act + A_HMID; E.pwt = (const float*)(F.ws + WS_PWT); E.tile_base = rt.tile_base; E.tile_nv = rt.tile_nv;
    pg8::gemm_phase(F.lds, P, E);
    { const int rem = (P.ntiles * 2) % F.G; int nw = F.G - rem, rank = F.bid - rem;
      if (rem == 0 || nw < 64) { nw = F.G; rank = F.bid; }
      if (rank >= 0) { EpiY8 E2; E2.Y = F.act + A_YS; E2.tile_nv = nullptr; pg8::Dense d = dense(F, F.act + A_HS, F.wsm(l) + WO_SD, Mr, 1024, 256, 0); d.G = nw; d.c = rank; pg8::gemm_phase(F.lds, d, E2); } }
}
__device__ __forceinline__ void phase_g8(const Frame& F, int l, int Mr) {
    pg8::Grouped<false, true, 0x79797979, 0x79797979> P;
    P.A = (const bf16_t*)(F.act + A_HMID); P.W = (const bf16_t*)(F.ws + WS_WDN); P.estride = (size_t)1024 * 128; P.ncol0 = 0;
    const RouteTabs rt = route_tables(F, l, true); P.ntiles = rt.ntiles; P.tile_e = rt.tile_e; P.tile_base = rt.tile_base; P.tile_nv = rt.tile_nv; P.ptok = nullptr; P.nN = 4; P.K = 128; P.G = F.G; P.c = F.bid;
    EpiY8 E; E.Y = F.act + A_YH0; E.tile_nv = rt.tile_nv;
    pg8::gemm_phase(F.lds, P, E);
}

constexpr int NPH_LAYER = 11, NPHASE = 2 + DEPTH * NPH_LAYER;
__global__ void __launch_bounds__(NTHREADS) __attribute__((amdgpu_waves_per_eu(2, 2))) fwd_kernel(Params p) {
    extern __shared__ __attribute__((aligned(16))) unsigned char lds_raw[];
    Frame F; F.lds = (LAS unsigned char*)lds_raw; F.tid = threadIdx.x; F.lane = F.tid & 63; F.wid = __builtin_amdgcn_readfirstlane(F.tid >> 6);
    F.G = gridDim.x; F.bid = blockIdx.x; F.ws = p.ws; F.act = p.ws + WS_ACT;
    volatile LAS unsigned* bw = (volatile LAS unsigned*)(F.lds + LDS_MISC);
    if (F.tid < 4) bw[F.tid] = 0u;
    if (F.tid == 0) { LAS unsigned* q = (LAS unsigned*)(F.lds + LDS_PTRS);
#pragma unroll
        for (int i = 0; i < 30; ++i) { const unsigned long long v = (i < 29) ? (unsigned long long)p.in[i < 29 ? i : 0] : (unsigned long long)p.out; q[2 * i] = (unsigned)v; q[2 * i + 1] = (unsigned)(v >> 32); } }
    __syncthreads();
    XcdBarrier bar; bar.bar = (unsigned*)(p.ws + WS_CTL) + CW_BAR; bar.x = 0; bar.st = bw;
    if (p.use_bar) bar = xcd_barrier_post((unsigned*)(p.ws + WS_CTL) + CW_BAR, bw);
    int ph = 0;
#ifndef PH_ONLY
#define PH_ONLY -1
#endif
#define RUNX(idx, body) do { if (ph >= p.ph_lo && ph < p.ph_hi) { if (PH_ONLY < 0 || PH_ONLY == (idx)) { unsigned long long wsl = (unsigned long long)p.ws; asm volatile("" : "+s"(wsl)); F.ws = (unsigned char*)(__attribute__((address_space(1))) unsigned char*)wsl; F.act = F.ws + WS_ACT; body; } if (p.use_bar && ph + 1 < p.ph_hi) xcd_barrier(bar); } ++ph; } while (0)
    RUNX(0, phase_p0(F));
    RUNX(1, phase_e1(F));
#define LAYER(l) do { \
        const bool last = (l == DEPTH - 1); \
        const int Te = last ? TL : TT; \
        RUNX(2, { phase_g1(F, l); if (l == 0) { const int busy = (TT / 256) * (NINP / 256) + TT / 256 - 5 * F.G;     \
            if (busy > 0 && busy < F.G) setup_layer(F, 1, F.bid - busy, F.G - busy); else setup_layer(F, 1, F.bid, F.G); } }); \
          \
        RUNX(3, { if (F.bid & 1) phase_g2(F, l); phase_e3(F); if (!(F.bid & 1)) phase_g2(F, l); }); \
        RUNX(6, phase_att(F, l)); \
        RUNX(7, { phase_g4(F, l, Te); if (l == 0) { const int extra = (Te / 256) * 8 - 2 * F.G;   \
            if (extra > 0 && extra < F.G) conv_exp_all(F, 0, F.bid - extra, F.G - extra); else conv_exp_all(F, 0, F.bid, F.G); } }); \
        RUNX(8, phase_g5(F, l, Te)); \
        RUNX(9, phase_e5(F, l, Te)); \
        RUNX(10, phase_g6(F, l, Te)); \
        RUNX(11, phase_r1(F, l, Te)); \
        RUNX(13, phase_g7(F, l, Te)); \
        RUNX(14, phase_g8(F, l, Te)); \
        RUNX(15, { phase_e6(F, l, Te); if (!last) conv_exp_all(F, l + 1, F.bid, F.G); }); \
    } while (0)
    LAYER(0);
    LAYER(1);
#undef LAYER
#undef RUNX
}

extern "C" void kernel_launch(void* const* d_in, const int* in_sizes, int n_in, void* d_out, int out_size, void* d_ws, size_t ws_size, hipStream_t stream) {
    static int grid = 0;
    if (grid == 0) {
        if (n_in != 29 || out_size != TL * DM || ws_size < WS_END) {
            fprintf(stderr, "kernel_launch: expected 29 inputs, %d outputs, >= %zu bytes of workspace; got n_in %d, out %d, ws %zu; nothing launched\n", TL * DM, (size_t)WS_END, n_in, out_size, ws_size);
            grid = -1; return; }
        int dev = 0, cus = 0, per_cu = 0;
        if (hipGetDevice(&dev) != hipSuccess || hipDeviceGetAttribute(&cus, hipDeviceAttributeMultiprocessorCount, dev) != hipSuccess) { grid = -1; return; }
        if (hipFuncSetAttribute((const void*)fwd_kernel, hipFuncAttributeMaxDynamicSharedMemorySize, LDS_BYTES) != hipSuccess) { fprintf(stderr, "kernel_launch: hipFuncSetAttribute failed\n"); grid = -1; return; }
        if (hipOccupancyMaxActiveBlocksPerMultiprocessor(&per_cu, (const void*)fwd_kernel, NTHREADS, LDS_BYTES) != hipSuccess || per_cu < 1) {
            fprintf(stderr, "kernel_launch: occupancy query reports %d workgroups per CU\n", per_cu); (void)hipGetLastError(); }
        grid = cus < 256 ? cus : 256;
        if (grid != 256) fprintf(stderr, "kernel_launch: %d CUs; this build is laid out for 256\n", cus);
    }
    if (grid < 0) return;
    if (hipMemsetAsync((char*)d_ws + WS_CTL, 0, CTL_BYTES, stream) != hipSuccess) return;
    Params p{};
    for (int i = 0; i < 29; ++i) p.in[i] = (const float*)d_in[i];
    p.out = (float*)d_out; p.ws = (unsigned char*)d_ws; p.pad = 0;
#if KL_LAUNCH_MODE == 1
    p.ph_lo = 0; p.ph_hi = NPHASE; p.use_bar = 1;
    hipLaunchKernelGGL(fwd_kernel, dim3(grid), dim3(NTHREADS), LDS_BYTES, stream, p);
#else
    p.use_bar = 0;
    for (int i = 0; i < NPHASE; ++i) { p.ph_lo = i; p.ph_hi = i + 1; hipLaunchKernelGGL(fwd_kernel, dim3(grid), dim3(NTHREADS), LDS_BYTES, stream, p); }
#endif
}
```

```cpp
#include <hip/hip_runtime.h>
#include <cstdio>
#include <cstdint>

#ifndef KL_LAUNCH_MODE
#define KL_LAUNCH_MODE 1
#endif

#define LAS __attribute__((address_space(3)))
typedef unsigned short bf16_t;
typedef short bf16x8 __attribute__((ext_vector_type(8)));
typedef short s16x4 __attribute__((ext_vector_type(4)));
typedef float f32x4 __attribute__((ext_vector_type(4)));
typedef float f32x16 __attribute__((ext_vector_type(16)));
typedef unsigned u32x4 __attribute__((ext_vector_type(4)));
typedef int i32x4 __attribute__((ext_vector_type(4)));
typedef int i32x8 __attribute__((ext_vector_type(8)));
typedef unsigned u32x2 __attribute__((ext_vector_type(2)));
typedef float f32x2_t __attribute__((ext_vector_type(2)));
typedef __bf16 bf16x2_t __attribute__((ext_vector_type(2)));

constexpr int DM = 1024, NB = 4, SEQ = 4096, CTXL = 256, DEPTH = 2;
constexpr int TL = NB * SEQ;
constexpr int TC = NB * CTXL;
constexpr int TT = TL + TC;
constexpr int NIN = 5024, NINP = 5120;
constexpr int OFF_CQ = 0, OFF_CKV = 384, OFF_KR = 640, OFF_U = 672, OFF_QS = 1184, OFF_KS = 1696, OFF_VS = 1824, OFF_GL = 1952;
constexpr int NEXP = 64, TOPK = 8, DEXP = 256;
constexpr int MAXROWS = 155648;
constexpr int MAXTILES = MAXROWS / 256;
constexpr float NORM_EPS = 1e-6f;
constexpr float LOG2E = 1.4426950408889634f;
constexpr float MLA_QSCALE = 0.10206207261596577f * LOG2E;
constexpr float SWA_QSCALE = 0.125f * LOG2E;

constexpr size_t al256(size_t x) { return (x + 255) & ~(size_t)255; }
constexpr size_t WS_CTL = 0;
constexpr size_t CTL_BYTES = 65536;
constexpr int CW_BAR = 0;
constexpr int CW_CNT = 4096;
constexpr size_t WS_MOD = WS_CTL + CTL_BYTES;
constexpr size_t WS_TABM = WS_MOD + al256((size_t)DEPTH * 5 * 6144 * 4);
constexpr size_t WS_TABS = WS_TABM + 4096;
constexpr size_t WS_MISC = WS_TABS + 8192;
constexpr size_t WS_TILEE = WS_MISC + 256;
constexpr size_t WS_WSM = WS_TILEE + al256(MAXTILES * 4);
constexpr size_t WO_IN = 0;
constexpr size_t WO_UQ = WO_IN + (size_t)NINP * 1024 * 2;
constexpr size_t WO_K = WO_UQ + (size_t)768 * 384 * 2;
constexpr size_t WO_V = WO_K + (size_t)512 * 256 * 2;
constexpr size_t WO_COMB = WO_V + (size_t)512 * 256 * 2;
constexpr size_t WO_BRM = WO_COMB + (size_t)1024 * 512 * 2;
constexpr size_t WO_BRS = WO_BRM + (size_t)1024 * 512 * 2;
constexpr size_t WO_OUT = WO_BRS + (size_t)1024 * 512 * 2;
constexpr size_t WO_RS = WO_OUT + (size_t)1024 * 1024 * 2;
constexpr size_t WO_SD = WO_RS + (size_t)768 * 1024 * 2;
constexpr size_t WO_G8 = WO_SD + (size_t)1024 * 256 * 2;
constexpr size_t WO_I8 = WO_G8 + (size_t)3072 * 1024;
constexpr size_t WSM_LAYER = WO_I8 + (size_t)(2048 + 64) * 1024;
constexpr size_t WS_WGU = WS_WSM + DEPTH * WSM_LAYER;
constexpr size_t WS_WDN = WS_WGU + (size_t)NEXP * 512 * 1024 * 2;
constexpr size_t WS_X = WS_WDN + (size_t)NEXP * 1024 * 256 * 2;
constexpr size_t WS_H8 = WS_X + (size_t)TT * 1024 * 2;
constexpr size_t WS_PTOK = WS_X + (size_t)TT * 1024 * 3;
constexpr size_t WS_PWT = WS_PTOK + (size_t)NEXP * TT * 4;
constexpr size_t WS_LOGIT = WS_X + (size_t)TT * 1024 * 4;
static_assert(WS_PWT + (size_t)NEXP * TT * 4 + 4096 <= WS_LOGIT, "expert lists do not fit");
constexpr size_t WS_LOGIT2 = WS_LOGIT + (size_t)TT * 64 * 4;
constexpr size_t WS_TOKE = WS_LOGIT2 + (size_t)TT * 64 * 4;
constexpr size_t WS_TOKP = WS_TOKE + (size_t)TT * 8 * 4;
constexpr size_t WS_TOKW = WS_TOKP + (size_t)TT * 8 * 4;
constexpr size_t WS_TOKR = WS_TOKW + (size_t)TT * 8 * 4;
constexpr size_t WS_ROWT = WS_TOKR + (size_t)TT * 8 * 4;
constexpr size_t WS_ROWW = WS_ROWT + (size_t)MAXROWS * 4;
constexpr size_t WS_ACT = al256(WS_ROWW + (size_t)MAXROWS * 4);
constexpr size_t A_H = 0;
constexpr size_t A_SEG = A_H + (size_t)TT * 1024 * 2;
constexpr size_t A_CQ = A_SEG;
constexpr size_t A_CKV = A_CQ + (size_t)TT * 384 * 2;
constexpr size_t A_KR = A_CKV + (size_t)TT * 256 * 2;
constexpr size_t A_U = A_KR + (size_t)TT * 32 * 2;
constexpr size_t A_QSR = A_U + (size_t)TT * 512 * 2;
constexpr size_t A_KSR = A_QSR + (size_t)TT * 512 * 2;
constexpr size_t A_SEGEND = A_KSR + (size_t)TT * 128 * 2;
constexpr size_t A_QRAW = A_SEG;
constexpr size_t A_Q = A_H;
constexpr size_t A_YO = A_SEG;
constexpr size_t A_GATES = A_SEGEND;
constexpr size_t A_F = A_GATES;
constexpr size_t A_HS = A_F + al256((size_t)(TT + 1) * 1024 * 2);
constexpr size_t A_YS = A_HS + (size_t)TT * 256 * 2;
constexpr size_t A_F8 = A_YS + (size_t)TT * 1024 * 2;
constexpr size_t A_YH0 = A_YS + (size_t)TT * 1024 * 2;
constexpr size_t A_CQN = A_GATES + (size_t)TT * 3072 * 2;
constexpr size_t A_CKVN = A_CQN + (size_t)TT * 384 * 2;
constexpr size_t A_POOL = A_CKVN + (size_t)TT * 256 * 2;
constexpr size_t A_QS = A_POOL + (size_t)TT * 512 * 2;
constexpr size_t A_KS = A_QS + (size_t)TT * 512 * 2;
constexpr size_t A_VST = A_KS + (size_t)TT * 128 * 2;
constexpr size_t A_K = A_VST + (size_t)256 * TT * 2;
constexpr size_t A_VT = A_K + (size_t)TT * 768 * 2;
constexpr size_t A_YMLA = A_VT + (size_t)512 * TT * 2;
constexpr size_t A_YSWA = A_YMLA + (size_t)TT * 512 * 2;
constexpr size_t A_END = A_YSWA + (size_t)TT * 512 * 2;
constexpr size_t A_HMID = A_H;
static_assert(A_HMID + (size_t)MAXROWS * 256 * 2 <= A_GATES, "hmid overlaps f");
static_assert(A_YH0 + (size_t)MAXROWS * 512 * 2 <= A_END, "Y half does not fit");
static_assert(A_Q + (size_t)TT * 768 * 2 <= A_SEG, "Q does not fit");
constexpr size_t WS_END = WS_ACT + A_END;

#define XB_TMO      128
#define XB_XCNT(j)  (256  + 64 * (j))
#define XB_XSUB(j)  (1280 + 64 * (j))
#define XB_XGEN(j)  (2304 + 64 * (j))
#define XB_TOP      3328
#define XB_TOPGEN   3392
#define XCD_BAR_WORDS 3456
#define XB_SPIN_CAP (1u << 18)
__device__ __forceinline__ unsigned xb_ld(unsigned* p)              { return __hip_atomic_load(p, __ATOMIC_RELAXED, __HIP_MEMORY_SCOPE_AGENT); }
__device__ __forceinline__ unsigned xb_add(unsigned* p, unsigned v) { return __hip_atomic_fetch_add(p, v, __ATOMIC_RELAXED, __HIP_MEMORY_SCOPE_AGENT); }
__device__ __forceinline__ unsigned xb_xcc_id() { return (unsigned)__builtin_amdgcn_s_getreg((3 << 11) | 20) & 0xFu; }
#define XB_SPIN(cond, bar) do { unsigned _sp = 0; while (cond) { __builtin_amdgcn_s_sleep(1); \
    if ((++_sp & 255u) == 0u) { if (xb_ld(&(bar)[XB_TMO])) break; if (_sp > XB_SPIN_CAP) { atomicAdd(&(bar)[XB_TMO], 1u); break; } } } } while (0)
struct XcdBarrier { unsigned* bar; unsigned x; volatile LAS unsigned* st; };
__device__ __forceinline__ XcdBarrier xcd_barrier_post(unsigned* bar, volatile LAS unsigned* st) {
    XcdBarrier b; b.bar = bar; b.x = xb_xcc_id(); b.st = st;
    if (threadIdx.x == 0) (void)xb_add(&bar[XB_XCNT(b.x)], 1u);
    return b;
}
__device__ __forceinline__ void xcd_barrier_complete(unsigned* bar, unsigned x, unsigned& nloc, unsigned& nx) {
    const unsigned G = gridDim.x * gridDim.y * gridDim.z;
    unsigned sum, cnt, mine, sp = 0u;
    for (;;) {
        sum = 0u; cnt = 0u; mine = 0u;
#pragma unroll
        for (unsigned j = 0; j < 16; ++j) { const unsigned c = xb_ld(&bar[XB_XCNT(j)]); sum += c; cnt += (c > 0u) ? 1u : 0u; mine = (j == x) ? c : mine; }
        if (sum == G) break;
        __builtin_amdgcn_s_sleep(1);
        if ((++sp & 255u) == 0u) { if (xb_ld(&bar[XB_TMO])) break; if (sp > XB_SPIN_CAP) { atomicAdd(&bar[XB_TMO], 1u); break; } }
    }
    nloc = mine > 0u ? mine : 1u; nx = cnt > 0u ? cnt : 1u;
}
__device__ __forceinline__ void xcd_barrier(const XcdBarrier& b) {
    asm volatile("s_waitcnt vmcnt(0)" ::: "memory");
    __syncthreads();
    if (threadIdx.x == 0) {
        unsigned* bar = b.bar;
        __builtin_amdgcn_s_waitcnt(0);
        unsigned nloc = b.st[0], nx = b.st[1];
        if (nloc == 0u) { xcd_barrier_complete(bar, b.x, nloc, nx); b.st[0] = nloc; b.st[1] = nx; }
        const unsigned old = xb_add(&bar[XB_XSUB(b.x)], 1u);
        const unsigned gen = old / nloc;
        if (old + 1u == (gen + 1u) * nloc) {
            __builtin_amdgcn_fence(__ATOMIC_RELEASE, "agent");
            asm volatile("s_waitcnt vmcnt(0)" ::: "memory");
            const unsigned og = xb_add(&bar[XB_TOP], 1u);
            const unsigned tg = og / nx;
            if (og + 1u == (tg + 1u) * nx) xb_add(&bar[XB_TOPGEN], 1u);
            else XB_SPIN(xb_ld(&bar[XB_TOPGEN]) == tg, bar);
            __builtin_amdgcn_fence(__ATOMIC_ACQUIRE, "agent");
            xb_add(&bar[XB_XGEN(b.x)], 1u);
            asm volatile("s_waitcnt vmcnt(0)" ::: "memory");
        } else {
            XB_SPIN(xb_ld(&bar[XB_XGEN(b.x)]) == gen, bar);
            __builtin_amdgcn_fence(__ATOMIC_ACQUIRE, "agent");
            asm volatile("s_waitcnt vmcnt(0)" ::: "memory");
        }
    }
    __syncthreads();
}

__device__ __forceinline__ unsigned cvtpk(float lo, float hi) { f32x2_t v = {lo, hi}; bf16x2_t b = __builtin_convertvector(v, bf16x2_t); return __builtin_bit_cast(unsigned, b); }
__device__ __forceinline__ bf16_t f2bf(float f) { return (bf16_t)(cvtpk(f, 0.f) & 0xffffu); }
__device__ __forceinline__ float bflo(unsigned w) { return __uint_as_float(w << 16); }
__device__ __forceinline__ float bfhi(unsigned w) { return __uint_as_float(w & 0xffff0000u); }
__device__ __forceinline__ float bf2f(bf16_t b) { return __uint_as_float(((unsigned)b) << 16); }
__device__ __forceinline__ void unpack8(const u32x4& w, float (&a)[8]) { a[0] = bflo(w.x); a[1] = bfhi(w.x); a[2] = bflo(w.y); a[3] = bfhi(w.y); a[4] = bflo(w.z); a[5] = bfhi(w.z); a[6] = bflo(w.w); a[7] = bfhi(w.w); }
__device__ __forceinline__ u32x4 packf8(const float (&a)[8]) { u32x4 w; w.x = cvtpk(a[0], a[1]); w.y = cvtpk(a[2], a[3]); w.z = cvtpk(a[4], a[5]); w.w = cvtpk(a[6], a[7]); return w; }
__device__ __forceinline__ float fast_sigmoid(float x) { return __builtin_amdgcn_rcpf(1.0f + __builtin_amdgcn_exp2f(-x * LOG2E)); }
__device__ __forceinline__ float fast_silu(float x) { return x * fast_sigmoid(x); }
__device__ __forceinline__ unsigned fp8x4(float a, float b, float c, float d) { int w = 0; w = __builtin_amdgcn_cvt_pk_fp8_f32(a, b, w, false); w = __builtin_amdgcn_cvt_pk_fp8_f32(c, d, w, true); return (unsigned)w; }
constexpr float A8_SCALE = 32.0f;
__device__ __forceinline__ float wave_sum(float v) {
#pragma unroll
    for (int o = 32; o > 0; o >>= 1) v += __shfl_xor(v, o);
    return v;
}
__device__ __forceinline__ unsigned ld_ctl(const unsigned* p) { return __hip_atomic_load(p, __ATOMIC_RELAXED, __HIP_MEMORY_SCOPE_AGENT); }
__device__ __forceinline__ int ld_ctl(const int* p) { return __hip_atomic_load(p, __ATOMIC_RELAXED, __HIP_MEMORY_SCOPE_AGENT); }
__device__ __forceinline__ void sincos_small(float a, float& s, float& c) {
    const float k = rintf(a * 0.63661977236758134f);
    float r = fmaf(k, -1.57079637050628662109375f, a);
    r = fmaf(k, 4.37113900018624283e-8f, r);
    const float r2 = r * r;
    const float sr = r + r * r2 * (-1.6666667163e-1f + r2 * (8.3333337680e-3f + r2 * (-1.9841270114e-4f + r2 * 2.7557314297e-6f)));
    const float cr = 1.0f + r2 * (-0.5f + r2 * (4.1666667908e-2f + r2 * (-1.3888889225e-3f + r2 * (2.4801587642e-5f - r2 * 2.7557314297e-7f))));
    const int q = ((int)k) & 3;
    s = (q == 0) ? sr : (q == 1) ? cr : (q == 2) ? -sr : -cr;
    c = (q == 0) ? cr : (q == 1) ? -sr : (q == 2) ? -cr : sr;
}
__device__ __forceinline__ int tok_modrow(int t) { return t < TL ? (t >> 12) : 4; }

namespace pg8 {
constexpr int BM = 256, BK = 64, HALF = 128, HTB = HALF * BK * 2, STAGE_BYTES = 8 * HTB, NXCD = 8, WGM = 8;
__host__ __device__ __forceinline__ int lds_byte(int r, int c) { const int st = (r >> 4) * 2 + (c >> 5), rr = r & 15, cc = c & 31, ob = rr * 64 + cc * 2; return st * 1024 + (ob ^ (((ob >> 9) & 1) << 5)); }
__host__ __device__ __forceinline__ void stage_rc(int b, int& R, int& C) { const int st = b / 1024, sb = b % 1024, swz = sb ^ (((sb >> 9) & 1) << 5); R = (st >> 1) * 16 + swz / 64; C = (st & 1) * 32 + (swz % 64) / 2; }
__host__ __device__ __forceinline__ int perm32(int rho) { const int n = rho >> 4, i = rho & 15; return 8 * (i >> 2) + 4 * n + (i & 3); }
struct Unit { int pm, pn, br; };
__device__ __forceinline__ bool static_next(int nM, int nN, int G, int c, int i, Unit& u) {
    const int nwg = nM * nN; const long L = (long)i * G + c; if (L >= nwg) return false;
    int wgid = (int)L; { const int q = nwg / NXCD, r = nwg % NXCD, xcd = wgid % NXCD, off = wgid / NXCD; wgid = (xcd < r ? xcd * (q + 1) : r * (q + 1) + (xcd - r) * q) + off; }
    const int nig = WGM * nN, gid = wgid / nig, fm = gid * WGM, gsz = (nM - fm) < WGM ? (nM - fm) : WGM;
    u.pm = fm + ((wgid % nig) % gsz); u.pn = (wgid % nig) / gsz; return true;
}
template <bool F8 = false, int SW_ = 0, int SX_ = 0> struct DenseT {
    static constexpr bool GATHER = false, FP8 = F8, HALFN = false; static constexpr int SW = SW_, SX = SX_;
    const bf16_t* A; const bf16_t* Bt; int nM, nN, K, G, c;
    __device__ __forceinline__ bool next(int i, Unit& u) const { return static_next(nM, nN, G, c, i, u); }
    __device__ __forceinline__ const char* a_base(const Unit& u) const { return (const char*)A + (size_t)u.pm * 256 * K * 2; }
    __device__ __forceinline__ const char* b_base(const Unit& u) const { return (const char*)Bt + (size_t)u.pn * 256 * K * 2; }
    __device__ __forceinline__ unsigned row_off(const Unit&, int) const { return 0u; }
};
typedef DenseT<> Dense;
template <bool GATH, bool F8 = false, int SW_ = 0x7F7F7F7F, int SX_ = 0x7F7F7F7F> struct Grouped {
    static constexpr bool GATHER = GATH, FP8 = F8, HALFN = false; static constexpr int SW = SW_, SX = SX_;
    const bf16_t* A; const bf16_t* W; size_t estride; int ncol0; const LAS int* tile_e; const LAS int* tile_base; const LAS int* tile_nv; const int* ptok; int ntiles, nN, K, G, c;
    __device__ __forceinline__ bool next(int i, Unit& u) const { return static_next(ntiles, nN, G, c, i, u); }
    __device__ __forceinline__ const char* a_base(const Unit& u) const { return GATH ? (const char*)A : (const char*)A + (size_t)u.pm * 256 * K * 2; }
    __device__ __forceinline__ const char* b_base(const Unit& u) const { const int e = __builtin_amdgcn_readfirstlane(tile_e[u.pm]); return (const char*)W + ((size_t)e * estride + (size_t)(ncol0 + 256 * u.pn) * K) * 2; }
    __device__ __forceinline__ unsigned row_off(const Unit& u, int r) const { const int nv = tile_nv[u.pm]; const int tok = ptok[tile_base[u.pm] + (r < nv ? r : 0)]; return (unsigned)(r < nv ? tok : TT) * (unsigned)(K * 2); }
};

template <bool F8 = false, int SW_ = 0, int SX_ = 0> struct Merge3HT {
    static constexpr bool GATHER = false, FP8 = F8, HALFN = true; static constexpr int SW = SW_, SX = SX_;
    const bf16_t* A0; const bf16_t* A1; const bf16_t* A2; const bf16_t* B0; const bf16_t* B1; const bf16_t* B2; int nM, nN, K, G, c;
    __device__ __forceinline__ bool next(int i, Unit& u) const {
        const int j = i / 3; u.br = i - 3 * j;
        const int nwg = nM * nN; const long L = (long)j * G + c; if (L >= nwg) return false;
        int wgid = (int)L; { const int q = nwg / NXCD, r = nwg % NXCD, xcd = wgid % NXCD, off = wgid / NXCD; wgid = (xcd < r ? xcd * (q + 1) : r * (q + 1) + (xcd - r) * q) + off; }
        u.pm = wgid / nN; u.pn = wgid % nN; return true; }
    __device__ __forceinline__ const char* a_base(const Unit& u) const { const long d1 = (const char*)A1 - (const char*)A0, d2 = (const char*)A2 - (const char*)A0;
        return (const char*)A0 + (long)(u.br & 1) * d1 + (long)(u.br >> 1) * d2 + (size_t)u.pm * 256 * K * 2; }
    __device__ __forceinline__ const char* b_base(const Unit& u) const { const long d1 = (const char*)B1 - (const char*)B0, d2 = (const char*)B2 - (const char*)B0;
        return (const char*)B0 + (long)(u.br & 1) * d1 + (long)(u.br >> 1) * d2 + (size_t)u.pn * 128 * K * 2; }
    __device__ __forceinline__ unsigned row_off(const Unit&, int) const { return 0u; }
};

#ifndef PG8_SP2
#define PG8_SP2 1
#endif
template <bool F8> struct Frag { bf16x8 k0, k1;
    __device__ __forceinline__ void load(const LAS unsigned char* p) { k0 = *(const LAS bf16x8*)p; k1 = *(const LAS bf16x8*)(p + 1024); } };
template <> struct Frag<true> { i32x8 w;
    __device__ __forceinline__ void load(const LAS unsigned char* p) { w = *(const LAS i32x8*)p; } };
template <class Epi, class Prob>
__device__ __forceinline__ void gemm_phase(LAS unsigned char* lds, const Prob& P, const Epi& E) {
    constexpr bool SP2 = PG8_SP2 != 0, ALIGN_EPI = PG8_SP2 != 0, HN = Prob::HALFN;
    const int tid = threadIdx.x, wid = __builtin_amdgcn_readfirstlane(tid >> 6), lane = tid & 63, wr = wid >> 2, wc = wid & 3, fr = lane & 15, fq = lane >> 4;
    const int K = P.K, nt = K / BK;
    int Rst[2]; unsigned voffA[2], voffB[2];
#pragma unroll
    for (int i = 0; i < 2; ++i) { int R, C; stage_rc(tid * 16 + i * 8192, R, C); const int Rb = (R & ~31) + perm32(R & 31); Rst[i] = R;
        voffA[i] = (unsigned)(R * K + C) * 2u; voffB[i] = (unsigned)(Rb * K + C) * 2u; if (Prob::GATHER) voffA[i] = (unsigned)C * 2u; }
    const size_t kstep = (size_t)(BK * 2);
    const size_t hstep = (size_t)HALF * K * 2;
    const size_t hstepA = Prob::GATHER ? 0 : hstep;
    const unsigned ldsw = (unsigned)wid * 1024u;
    const int aoff = Prob::FP8 ? lds_byte(wr * 64 + fr, fq * 16) : lds_byte(wr * 64 + fr, fq * 8), boff = Prob::FP8 ? lds_byte(wc * 32 + fr, fq * 16) : lds_byte(wc * 32 + fr, fq * 8);
#define PG8_SA(b, h) (((b) * 2 + (h)) * HTB)
#define PG8_SB(b, h) ((4 + (b) * 2 + (h)) * HTB)
#define PG8_STAGE(bufoff, gbase, voff) do { _Pragma("unroll") for (int _i = 0; _i < 2; ++_i) \
        __builtin_amdgcn_global_load_lds((const unsigned*)((const char*)(gbase) + (voff)[_i]), (LAS unsigned*)(lds + (bufoff) + ldsw + _i * 8192), 16, 0, 0); } while (0)
#define PG8_STAGEA(bufoff, gbase, h, nx) do { _Pragma("unroll") for (int _i = 0; _i < 2; ++_i) { \
        const unsigned _ro = Prob::GATHER ? ((nx) ? groN[h][_i] : groC[h][_i]) : 0u; \
        __builtin_amdgcn_global_load_lds((const unsigned*)(((const char*)(gbase) + (size_t)(h) * hstepA) + (unsigned)(_ro + voffA[_i])), (LAS unsigned*)(lds + (bufoff) + ldsw + _i * 8192), 16, 0, 0); } } while (0)
#define PG8_LDA(dst, b, h) do { _Pragma("unroll") for (int m = 0; m < 4; ++m) dst[m].load(lds + PG8_SA(b, h) + aoff + m * 2048); } while (0)
#define PG8_LDB(dst, b, h) do { _Pragma("unroll") for (int n = 0; n < 2; ++n) dst[n].load(lds + PG8_SB(b, h) + boff + n * 2048); } while (0)
#define PG8_MMA(ai, bj, At, Bt) do { __builtin_amdgcn_s_setprio(1); _Pragma("unroll") for (int m = 0; m < 4; ++m) _Pragma("unroll") for (int n = 0; n < 2; ++n) { \
        if constexpr (Prob::FP8) {   \
              \
            asm volatile("v_mfma_scale_f32_16x16x128_f8f6f4 %0, %1, %2, %0, %3, %3 op_sel_hi:[0,0,0]" : "+v"(acc[ai][bj][m][n]) : "v"(Bt[n].w), "v"(At[m].w), "v"(mxscale)); \
        } else { acc[ai][bj][m][n] = __builtin_amdgcn_mfma_f32_16x16x32_bf16(Bt[n].k0, At[m].k0, acc[ai][bj][m][n], 0, 0, 0); \
                 acc[ai][bj][m][n] = __builtin_amdgcn_mfma_f32_16x16x32_bf16(Bt[n].k1, At[m].k1, acc[ai][bj][m][n], 0, 0, 0); } } \
        __builtin_amdgcn_s_setprio(0); } while (0)
#define PG8_WAIT_V(n) asm volatile("s_waitcnt vmcnt(" #n ")" ::: "memory")
#define PG8_STAGE_B1(bufoff, gbase, voff) do { if constexpr (!HN) PG8_STAGE(bufoff, gbase, voff); } while (0)
#define PG8_LDB1(dst, b, h) do { if constexpr (!HN) PG8_LDB(dst, b, h); } while (0)
#define PG8_MMA1(ai, bj, At, Bt) do { if constexpr (!HN) PG8_MMA(ai, bj, At, Bt); } while (0)
#define PG8_WAIT_LOOP do { if constexpr (HN) PG8_WAIT_V(6); else PG8_WAIT_V(8); } while (0)
#define PG8_WAIT_L(n) asm volatile("s_waitcnt lgkmcnt(" #n ")" ::: "memory")
#define PG8_BAR __builtin_amdgcn_s_barrier()
#define PG8_SCHED __builtin_amdgcn_sched_barrier(0)
    Unit cur, nxt; int ui = 0;
    if (!P.next(0, cur)) return;
    f32x4 acc[2][2][4][2];
#pragma unroll
    for (int a = 0; a < 2; ++a)
#pragma unroll
        for (int b = 0; b < 2; ++b)
#pragma unroll
            for (int m = 0; m < 4; ++m)
#pragma unroll
                for (int n = 0; n < 2; ++n) acc[a][b][m][n] = (f32x4){0.f, 0.f, 0.f, 0.f};
    Frag<Prob::FP8> At[4], B0[2], B1[2];
    const int mxscale = Prob::SW;
    unsigned groC[2][2] = {{0u, 0u}, {0u, 0u}}, groN[2][2] = {{0u, 0u}, {0u, 0u}};
    if (Prob::GATHER) {
#pragma unroll
        for (int h = 0; h < 2; ++h)
#pragma unroll
            for (int i = 0; i < 2; ++i) groC[h][i] = P.row_off(cur, h * HALF + Rst[i]);
    }
    const char* cA = P.a_base(cur); const char* cB = P.b_base(cur);
    if constexpr (SP2) {
        PG8_STAGE(PG8_SB(0, 0), cB, voffB); PG8_STAGE_B1(PG8_SB(0, 1), cB + hstep, voffB); PG8_STAGEA(PG8_SA(0, 0), cA, 0, false); PG8_STAGEA(PG8_SA(0, 1), cA, 1, false);
        if (wr == 1) PG8_BAR;
        PG8_WAIT_V(2); PG8_BAR;
        PG8_STAGE(PG8_SB(1, 0), cB + kstep, voffB); PG8_STAGEA(PG8_SA(1, 0), cA + kstep, 0, false); PG8_STAGE_B1(PG8_SB(1, 1), cB + hstep + kstep, voffB);
        if constexpr (HN) PG8_WAIT_V(4); else PG8_WAIT_V(6);
        PG8_BAR;
    } else {
        PG8_STAGE(PG8_SB(0, 0), cB, voffB); PG8_STAGEA(PG8_SA(0, 0), cA, 0, false); PG8_STAGE(PG8_SB(0, 1), cB + hstep, voffB); PG8_STAGEA(PG8_SA(0, 1), cA, 1, false);
        if (wr == 1) PG8_BAR;
        PG8_WAIT_V(4); PG8_BAR;
        PG8_STAGE(PG8_SB(1, 0), cB + kstep, voffB); PG8_STAGEA(PG8_SA(1, 0), cA + kstep, 0, false); PG8_STAGE(PG8_SB(1, 1), cB + hstep + kstep, voffB);
        PG8_WAIT_V(6); PG8_BAR;
    }
    typename Epi::State est;
    for (;;) {
        const bool has_next = P.next(ui + 1, nxt);
        if constexpr (HN) E.prefetch(est, cur, wr, wc, fr, fq);
        const char* nA = has_next ? P.a_base(nxt) : cA; const char* nB = has_next ? P.b_base(nxt) : cB;
        if (Prob::GATHER) {
            const int pmn = has_next ? nxt.pm : cur.pm; Unit un; un.pm = pmn; un.pn = 0;
#pragma unroll
            for (int h = 0; h < 2; ++h)
#pragma unroll
                for (int i = 0; i < 2; ++i) groN[h][i] = P.row_off(un, h * HALF + Rst[i]);
        }
        for (int t = 0; t < nt; t += 2) {
            const bool last = (t == nt - 2);
            const char* a1 = cA + (size_t)(t + 1) * kstep;
            const char* a2 = last ? nA : cA + (size_t)(t + 2) * kstep; const char* b2 = last ? nB : cB + (size_t)(t + 2) * kstep;
            const char* a3 = a2 + kstep; const char* b3 = b2 + kstep;
            if constexpr (SP2) {
            PG8_LDB(B0, 0, 0); PG8_LDB1(B1, 0, 1); PG8_SCHED; PG8_LDA(At, 0, 0); PG8_STAGEA(PG8_SA(1, 1), a1, 1, false);
            PG8_WAIT_LOOP; PG8_WAIT_L(0); PG8_BAR; PG8_MMA(0, 0, At, B0); PG8_MMA1(0, 1, At, B1); PG8_BAR; PG8_SCHED;
            PG8_LDA(At, 0, 1); PG8_STAGE(PG8_SB(0, 0), b2, voffB); PG8_STAGE_B1(PG8_SB(0, 1), b2 + hstep, voffB); PG8_STAGEA(PG8_SA(0, 0), a2, 0, last);
            PG8_WAIT_LOOP; PG8_WAIT_L(0); PG8_BAR; PG8_MMA(1, 0, At, B0); PG8_MMA1(1, 1, At, B1); PG8_BAR; PG8_SCHED;
            PG8_LDB(B0, 1, 0); PG8_LDB1(B1, 1, 1); PG8_SCHED; PG8_LDA(At, 1, 0); PG8_STAGEA(PG8_SA(0, 1), a2, 1, last);
            PG8_WAIT_LOOP; PG8_WAIT_L(0); PG8_BAR; PG8_MMA(0, 0, At, B0); PG8_MMA1(0, 1, At, B1); PG8_BAR; PG8_SCHED;
            PG8_LDA(At, 1, 1); PG8_STAGE(PG8_SB(1, 0), b3, voffB); PG8_STAGE_B1(PG8_SB(1, 1), b3 + hstep, voffB); PG8_STAGEA(PG8_SA(1, 0), a3, 0, last);
            PG8_WAIT_LOOP; PG8_WAIT_L(0); PG8_BAR; PG8_MMA(1, 0, At, B0); PG8_MMA1(1, 1, At, B1); PG8_BAR; PG8_SCHED;
            } else {
            PG8_LDB(B0, 0, 0); PG8_SCHED; PG8_LDA(At, 0, 0); PG8_STAGEA(PG8_SA(1, 1), a1, 1, false);
            PG8_WAIT_L(8); PG8_BAR; PG8_WAIT_L(0); PG8_MMA(0, 0, At, B0); PG8_BAR; PG8_SCHED;
            PG8_LDB(B1, 0, 1); PG8_STAGE(PG8_SB(0, 0), b2, voffB);
            PG8_BAR; PG8_WAIT_L(0); PG8_MMA(0, 1, At, B1); PG8_BAR;
            PG8_LDA(At, 0, 1); PG8_STAGEA(PG8_SA(0, 0), a2, 0, last);
            PG8_BAR; PG8_WAIT_L(0); PG8_MMA(1, 0, At, B0); PG8_BAR; PG8_SCHED;
            PG8_STAGE(PG8_SB(0, 1), b2 + hstep, voffB);
            PG8_WAIT_V(6); PG8_BAR; PG8_MMA(1, 1, At, B1); PG8_BAR;
            PG8_LDB(B0, 1, 0); PG8_SCHED; PG8_LDA(At, 1, 0); PG8_STAGEA(PG8_SA(0, 1), a2, 1, last);
            PG8_WAIT_L(8); PG8_BAR; PG8_WAIT_L(0); PG8_MMA(0, 0, At, B0); PG8_BAR; PG8_SCHED;
            PG8_LDB(B1, 1, 1); PG8_STAGE(PG8_SB(1, 0), b3, voffB);
            PG8_BAR; PG8_WAIT_L(0); PG8_MMA(0, 1, At, B1); PG8_BAR;
            PG8_LDA(At, 1, 1); PG8_STAGEA(PG8_SA(1, 0), a3, 0, last);
            PG8_BAR; PG8_WAIT_L(0); PG8_MMA(1, 0, At, B0); PG8_BAR; PG8_SCHED;
            PG8_STAGE(PG8_SB(1, 1), b3 + hstep, voffB);
            PG8_WAIT_V(6); PG8_BAR; PG8_MMA(1, 1, At, B1); PG8_BAR;
                    }
        }
        if constexpr (ALIGN_EPI) { if (wr == 0) PG8_BAR; }
        if constexpr (Prob::FP8) asm volatile("s_nop 15\n\ts_nop 7" ::: "memory");
        if constexpr (HN) E.run(acc, est, cur, wr, wc, fr, fq); else E(acc, cur, wr, wc, fr, fq);
        if (!has_next) break;
#pragma unroll
        for (int a = 0; a < 2; ++a)
#pragma unroll
            for (int b = 0; b < 2; ++b)
#pragma unroll
                for (int m = 0; m < 4; ++m)
#pragma unroll
                    for (int n = 0; n < 2; ++n) acc[a][b][m][n] = (f32x4){0.f, 0.f, 0.f, 0.f};
        cur = nxt; cA = nA; cB = nB; ++ui;
        if (Prob::GATHER) {
#pragma unroll
            for (int h = 0; h < 2; ++h)
#pragma unroll
                for (int i = 0; i < 2; ++i) groC[h][i] = groN[h][i];
        }
        if constexpr (ALIGN_EPI) { if (wr == 1) PG8_BAR; }
    }
    PG8_WAIT_V(0);
    if constexpr (!ALIGN_EPI) { if (wr == 0) PG8_BAR; }
    PG8_BAR;
#undef PG8_SA
#undef PG8_SB
#undef PG8_STAGE
#undef PG8_STAGEA
#undef PG8_LDA
#undef PG8_LDB
#undef PG8_MMA
#undef PG8_WAIT_V
#undef PG8_STAGE_B1
#undef PG8_LDB1
#undef PG8_MMA1
#undef PG8_WAIT_LOOP
#undef PG8_WAIT_L
#undef PG8_BAR
#undef PG8_SCHED
}
}

#define EPI_ARGS const f32x4 (&acc)[2][2][4][2], const pg8::Unit& u, int wr, int wc, int fr, int fq
__device__ __forceinline__ u32x4 pack8(const f32x4& a, const f32x4& b) { u32x4 w; w.x = cvtpk(a[0], a[1]); w.y = cvtpk(a[2], a[3]); w.z = cvtpk(b[0], b[1]); w.w = cvtpk(b[2], b[3]); return w; }

struct EpiStore { struct State {};
    bf16_t* O; int ldo, lgin, gout, mrows;
    __device__ __forceinline__ void operator()(EPI_ARGS) const {
        const int row0 = u.pm * 256 + wr * 64 + fr;
#pragma unroll
        for (int bj = 0; bj < 2; ++bj) {
            const int c8 = u.pn * 256 + bj * 128 + wc * 32 + 8 * fq;
            const int dc = ((c8 >> lgin) * gout) + (c8 & ((1 << lgin) - 1));
#pragma unroll
            for (int ai = 0; ai < 2; ++ai)
#pragma unroll
                for (int m = 0; m < 4; ++m) { const int row = row0 + ai * 128 + m * 16;
                    *(u32x4*)(O + (size_t)row * ldo + dc) = pack8(acc[ai][bj][m][0], acc[ai][bj][m][1]); }
        }
    }
};
template <int W> __device__ __forceinline__ void rstd_rows(const bf16_t* src, int row0, int n, LAS float* tab, int lane) {
    constexpr int NV = W / 128;
    const int g = lane >> 4, sl = lane & 15;
    for (int i0 = 0; i0 < n; i0 += 16) {
        u32x4 w[4][NV];
#pragma unroll
        for (int p = 0; p < 4; ++p) { const bf16_t* q = src + (size_t)(row0 + i0 + 4 * p + g) * W + sl * (W / 16);
#pragma unroll
            for (int v = 0; v < NV; ++v) w[p][v] = *(const u32x4*)(q + 8 * v); }
#pragma unroll
        for (int p = 0; p < 4; ++p) { float ss = 0.f;
#pragma unroll
            for (int v = 0; v < NV; ++v)
#pragma unroll
                for (int e = 0; e < 4; ++e) { const float a = bflo(w[p][v][e]), b = bfhi(w[p][v][e]); ss += a * a + b * b; }
            ss += __shfl_xor(ss, 8); ss += __shfl_xor(ss, 4); ss += __shfl_xor(ss, 2); ss += __shfl_xor(ss, 1);
            if (sl == 0) tab[i0 + 4 * p + g] = rsqrtf(ss * (1.0f / (float)W) + NORM_EPS); }
    }
    asm volatile("s_waitcnt lgkmcnt(0)" ::: "memory");
}
template <int W> struct EpiStoreRS { struct State {};
    bf16_t* O; int ldo, lgin, gout; const bf16_t* src; LAS float* tab;
    __device__ __forceinline__ void operator()(EPI_ARGS) const {
        const int lane = fq * 16 + fr; LAS float* t = tab + wr * 128;
        { const int idx0 = wc * 32, ai0 = idx0 >> 6, loc0 = idx0 & 63; rstd_rows<W>(src, u.pm * 256 + ai0 * 128 + wr * 64 + loc0, 32, t + idx0, lane); }
        __syncthreads();
        const int row0 = u.pm * 256 + wr * 64 + fr;
#pragma unroll
        for (int bj = 0; bj < 2; ++bj) {
            const int c8 = u.pn * 256 + bj * 128 + wc * 32 + 8 * fq;
            const int dc = ((c8 >> lgin) * gout) + (c8 & ((1 << lgin) - 1));
#pragma unroll
            for (int ai = 0; ai < 2; ++ai)
#pragma unroll
                for (int m = 0; m < 4; ++m) { const int row = row0 + ai * 128 + m * 16; const float sc = t[ai * 64 + m * 16 + fr];
                    *(u32x4*)(O + (size_t)row * ldo + dc) = pack8(acc[ai][bj][m][0] * sc, acc[ai][bj][m][1] * sc); }
        }
    }
};
struct EpiStoreCS { struct State {};
    bf16_t* O; int ldo; const bf16_t* src; LAS float* tab;
    __device__ __forceinline__ void operator()(EPI_ARGS) const {
        const int wid = wr * 4 + wc, lane = fq * 16 + fr; LAS float* t = tab + 256 + wid * 64;
        rstd_rows<256>(src, u.pn * 256 + wc * 32, 32, t, lane); rstd_rows<256>(src, u.pn * 256 + 128 + wc * 32, 32, t + 32, lane);
        const int row0 = u.pm * 256 + wr * 64 + fr;
#pragma unroll
        for (int bj = 0; bj < 2; ++bj) {
            const int c8 = u.pn * 256 + bj * 128 + wc * 32 + 8 * fq;
            const f32x4 s0 = *(const LAS f32x4*)(t + bj * 32 + 8 * fq), s1 = *(const LAS f32x4*)(t + bj * 32 + 8 * fq + 4);
#pragma unroll
            for (int ai = 0; ai < 2; ++ai)
#pragma unroll
                for (int m = 0; m < 4; ++m) { const int row = row0 + ai * 128 + m * 16;
                    *(u32x4*)(O + (size_t)row * ldo + c8) = pack8(acc[ai][bj][m][0] * s0, acc[ai][bj][m][1] * s1); }
        }
    }
};
struct EpiResid { struct State {};
    bf16_t* X; const float* xlat; const float* xctx; const float* mod2;
    __device__ __forceinline__ void operator()(EPI_ARGS) const {
        const int t0 = u.pm * 256; const float* gt = mod2 + (size_t)tok_modrow(t0) * 6 * 1024;
        const int row0 = t0 + wr * 64 + fr;
#pragma unroll
        for (int bj = 0; bj < 2; ++bj) {
            const int c8 = u.pn * 256 + bj * 128 + wc * 32 + 8 * fq;
            const f32x4 g0 = *(const f32x4*)(gt + c8), g1 = *(const f32x4*)(gt + c8 + 4);
#pragma unroll
            for (int ai = 0; ai < 2; ++ai)
#pragma unroll
                for (int m = 0; m < 4; ++m) { const int row = row0 + ai * 128 + m * 16; bf16_t* xo = X + (size_t)row * 1024 + c8;
                    f32x4 x0, x1;
                    if (xlat != nullptr) { const float* xr = (t0 < TL ? xlat + (size_t)row * 1024 : xctx + (size_t)(row - TL) * 1024) + c8; x0 = __builtin_nontemporal_load((const f32x4*)xr); x1 = __builtin_nontemporal_load((const f32x4*)(xr + 4)); }
                    else { const u32x4 w = *(const u32x4*)xo; x0 = (f32x4){bflo(w.x), bfhi(w.x), bflo(w.y), bfhi(w.y)}; x1 = (f32x4){bflo(w.z), bfhi(w.z), bflo(w.w), bfhi(w.w)}; }
                    *(u32x4*)xo = pack8(x0 + g0 * acc[ai][bj][m][0], x1 + g1 * acc[ai][bj][m][1]); }
        }
    }
};
struct EpiSeg { struct State {};
    unsigned char* act;
    __device__ __forceinline__ void operator()(EPI_ARGS) const {
        const int row0 = u.pm * 256 + wr * 64 + fr;
#pragma unroll
        for (int bj = 0; bj < 2; ++bj) {
            const int c32 = u.pn * 256 + bj * 128 + wc * 32;
            if (c32 >= OFF_VS) continue;
            size_t base; int ld, c0;
            if (c32 < OFF_CKV)      { base = A_CQ;  ld = 384; c0 = OFF_CQ; }
            else if (c32 < OFF_KR)  { base = A_CKV; ld = 256; c0 = OFF_CKV; }
            else if (c32 < OFF_U)   { base = A_KR;  ld = 32;  c0 = OFF_KR; }
            else if (c32 < OFF_QS)  { base = A_U;   ld = 512; c0 = OFF_U; }
            else if (c32 < OFF_KS)  { base = A_QS;  ld = 512; c0 = OFF_QS; }
            else                    { base = A_KSR; ld = 128; c0 = OFF_KS; }
            bf16_t* O = (bf16_t*)(act + base);
            const int dc = c32 - c0 + 8 * fq;
#pragma unroll
            for (int ai = 0; ai < 2; ++ai)
#pragma unroll
                for (int m = 0; m < 4; ++m) { const int row = row0 + ai * 128 + m * 16;
                    *(u32x4*)(O + (size_t)row * ld + dc) = pack8(acc[ai][bj][m][0], acc[ai][bj][m][1]); }
        }
    }
};
template <int PASS> struct EpiMerge { struct State {};
    bf16_t* out; const bf16_t* gates; int mrows;
    __device__ __forceinline__ void operator()(EPI_ARGS) const {
        const int row0 = u.pm * 256 + wr * 64 + fr;
#pragma unroll
        for (int bj = 0; bj < 2; ++bj) {
            const int c8 = u.pn * 256 + bj * 128 + wc * 32 + 8 * fq;
#pragma unroll
            for (int ai = 0; ai < 2; ++ai)
#pragma unroll
                for (int m = 0; m < 4; ++m) { const int row = row0 + ai * 128 + m * 16;
                    const u32x4 g = *(const u32x4*)(gates + (size_t)row * 3072 + PASS * 1024 + c8);
                    f32x4 v0 = acc[ai][bj][m][0], v1 = acc[ai][bj][m][1];
                    v0[0] *= bflo(g.x); v0[1] *= bfhi(g.x); v0[2] *= bflo(g.y); v0[3] *= bfhi(g.y);
                    v1[0] *= bflo(g.z); v1[1] *= bfhi(g.z); v1[2] *= bflo(g.w); v1[3] *= bfhi(g.w);
                    bf16_t* op = out + (size_t)row * 1024 + c8;
                    if (PASS > 0) { const u32x4 p = *(const u32x4*)op;
                        v0[0] += bflo(p.x); v0[1] += bfhi(p.x); v0[2] += bflo(p.y); v0[3] += bfhi(p.y);
                        v1[0] += bflo(p.z); v1[1] += bfhi(p.z); v1[2] += bflo(p.w); v1[3] += bfhi(p.w); }
                    *(u32x4*)op = pack8(v0, v1); }
        }
    }
};
__device__ __forceinline__ void swap16_pair(u32x2& x, u32x2& y) {
    auto r0 = __builtin_amdgcn_permlane16_swap(x.x, y.x, false, false); x.x = r0[0]; y.x = r0[1];
    auto r1 = __builtin_amdgcn_permlane16_swap(x.y, y.y, false, false); x.y = r1[0]; y.y = r1[1];
}
struct EpiGate8 { struct State {};
    unsigned char* gates;
    __device__ __forceinline__ void operator()(EPI_ARGS) const {
        const int row0 = u.pm * 256 + wr * 64 + fr + (fq & 1) * 16;
#pragma unroll
        for (int bj = 0; bj < 2; ++bj) {
            const int cb = u.pn * 256 + bj * 128 + wc * 32 + 16 * (fq >> 1);
#pragma unroll
            for (int ai = 0; ai < 2; ++ai)
#pragma unroll
                for (int mp = 0; mp < 4; mp += 2) { u32x2 p[2];
                    float g[16];
#pragma unroll
                    for (int h = 0; h < 2; ++h)
#pragma unroll
                        for (int e = 0; e < 4; ++e) { g[8 * h + e] = __builtin_amdgcn_exp2f(acc[ai][bj][mp + h][0][e]); g[8 * h + 4 + e] = __builtin_amdgcn_exp2f(acc[ai][bj][mp + h][1][e]); }
#pragma unroll
                    for (int e = 0; e < 16; ++e) g[e] = fmaf(g[e], 1.0f / 255.0f, 1.0f / 255.0f);
#pragma unroll
                    for (int e = 0; e < 16; ++e) g[e] = __builtin_amdgcn_rcpf(g[e]);
#pragma unroll
                    for (int h = 0; h < 2; ++h) { unsigned w0 = 0u, w1 = 0u;
#pragma unroll
                        for (int e = 0; e < 4; ++e) { w0 = __builtin_amdgcn_cvt_pk_u8_f32(g[8 * h + e], e, w0); w1 = __builtin_amdgcn_cvt_pk_u8_f32(g[8 * h + 4 + e], e, w1); }
                        p[h] = (u32x2){w0, w1}; }
                    swap16_pair(p[0], p[1]);
                    *(u32x4*)(gates + (size_t)(row0 + ai * 128 + mp * 16) * 3072 + cb) = (u32x4){p[0].x, p[0].y, p[1].x, p[1].y}; }
        }
    }
};
struct EpiMerge3H {
    struct State { u32x4 mg[2][4]; u32x4 gp[2][2]; };
    bf16_t* out; const unsigned char* gates;
    __device__ __forceinline__ void prefetch(State& st, const pg8::Unit& u, int wr, int wc, int fr, int fq) const {
        const int row0 = u.pm * 256 + wr * 64 + fr + (fq & 1) * 16, cb = u.pn * 128 + wc * 32 + 16 * (fq >> 1);
#pragma unroll
        for (int ai = 0; ai < 2; ++ai)
#pragma unroll
            for (int mp = 0; mp < 2; ++mp) st.gp[ai][mp] = *(const u32x4*)(gates + (size_t)(row0 + ai * 128 + mp * 32) * 3072 + u.br * 1024 + cb);
    }
    __device__ __forceinline__ void run(const f32x4 (&acc)[2][2][4][2], State& st, const pg8::Unit& u, int wr, int wc, int fr, int fq) const {
        const int row0 = u.pm * 256 + wr * 64 + fr, c8 = u.pn * 128 + wc * 32 + 8 * fq;
#pragma unroll
        for (int ai = 0; ai < 2; ++ai)
#pragma unroll
            for (int m = 0; m < 4; ++m) { u32x2 gx = (u32x2){st.gp[ai][m >> 1].x, st.gp[ai][m >> 1].y}, gy = (u32x2){st.gp[ai][m >> 1].z, st.gp[ai][m >> 1].w};
                swap16_pair(gx, gy); const u32x2 g = (m & 1) ? gy : gx; constexpr float q = 1.0f / 255.0f;
                f32x4 v0 = acc[ai][0][m][0] * q, v1 = acc[ai][0][m][1] * q;
                v0[0] *= (float)((g.x >> 0) & 0xffu); v0[1] *= (float)((g.x >> 8) & 0xffu); v0[2] *= (float)((g.x >> 16) & 0xffu); v0[3] *= (float)((g.x >> 24) & 0xffu);
                v1[0] *= (float)((g.y >> 0) & 0xffu); v1[1] *= (float)((g.y >> 8) & 0xffu); v1[2] *= (float)((g.y >> 16) & 0xffu); v1[3] *= (float)((g.y >> 24) & 0xffu);
                if (u.br != 0) { const u32x4 p = st.mg[ai][m];
                    v0[0] += bflo(p.x); v0[1] += bfhi(p.x); v0[2] += bflo(p.y); v0[3] += bfhi(p.y);
                    v1[0] += bflo(p.z); v1[1] += bfhi(p.z); v1[2] += bflo(p.w); v1[3] += bfhi(p.w); }
                const u32x4 w = pack8(v0, v1);
                if (u.br == 2) *(u32x4*)(out + (size_t)(row0 + ai * 128 + m * 16) * 1024 + c8) = w; else st.mg[ai][m] = w; }
    }
};
struct EpiG6 { struct State {};
    bf16_t* hs; float* logits; float* logits2; int mrows;
    __device__ __forceinline__ void operator()(EPI_ARGS) const {
        const int row0 = u.pm * 256 + wr * 64 + fr;
        if (u.pn < 2) {
            const int dc = u.pn * 128 + wc * 32 + 8 * fq;
#pragma unroll
            for (int ai = 0; ai < 2; ++ai)
#pragma unroll
                for (int mp = 0; mp < 4; mp += 2) { float sg[16];
#pragma unroll
                    for (int h = 0; h < 2; ++h)
#pragma unroll
                        for (int e = 0; e < 4; ++e) { sg[8 * h + e] = __builtin_amdgcn_exp2f(acc[ai][0][mp + h][0][e] * -LOG2E); sg[8 * h + 4 + e] = __builtin_amdgcn_exp2f(acc[ai][0][mp + h][1][e] * -LOG2E); }
#pragma unroll
                    for (int e = 0; e < 16; ++e) sg[e] = 1.0f + sg[e];
#pragma unroll
                    for (int e = 0; e < 16; ++e) sg[e] = __builtin_amdgcn_rcpf(sg[e]);
#pragma unroll
                    for (int h = 0; h < 2; ++h) { const int row = row0 + ai * 128 + (mp + h) * 16; f32x4 v0, v1;
#pragma unroll
                        for (int e = 0; e < 4; ++e) { v0[e] = acc[ai][0][mp + h][0][e] * sg[8 * h + e] * acc[ai][1][mp + h][0][e]; v1[e] = acc[ai][0][mp + h][1][e] * sg[8 * h + 4 + e] * acc[ai][1][mp + h][1][e]; }
                        *(u32x4*)(hs + (size_t)row * 256 + dc) = pack8(v0, v1); } }
        } else {
            const int dc = (wc & 1) * 32 + 8 * fq; float* lg = (wc < 2) ? logits : logits2;
#pragma unroll
            for (int ai = 0; ai < 2; ++ai)
#pragma unroll
                for (int m = 0; m < 4; ++m) { const int row = row0 + ai * 128 + m * 16;
                    float* lp = lg + (size_t)row * 64 + dc;
                    *(f32x4*)lp = acc[ai][0][m][0]; *(f32x4*)(lp + 4) = acc[ai][0][m][1]; }
        }
    }
};
typedef float f32x2v __attribute__((ext_vector_type(2)));
constexpr float Y8_SCALE = 16.0f;
constexpr float F8_SCALE = 8.0f, W8_SCALE = 128.0f, H8_SCALE = 32.0f;
struct EpiG7 { struct State {};
    unsigned char* hmid; const float* pwt; const LAS int* tile_base; const LAS int* tile_nv;
    __device__ __forceinline__ void operator()(EPI_ARGS) const {
        const int rl0 = wr * 64 + fr; const int tbase = tile_base[u.pm], nv = tile_nv[u.pm];
        const int cb = u.pn * 128 + wc * 32 + 16 * (fq >> 1);
#pragma unroll
        for (int ai = 0; ai < 2; ++ai)
#pragma unroll
            for (int mp = 0; mp < 4; mp += 2) { u32x2 p[2];
                float wr2[2];
#pragma unroll
                for (int h = 0; h < 2; ++h) { const int rl = rl0 + ai * 128 + (mp + h) * 16; wr2[h] = (rl < nv ? pwt[tbase + rl] : 0.f) * H8_SCALE; }
                float sg[16];
#pragma unroll
                for (int h = 0; h < 2; ++h)
#pragma unroll
                    for (int e = 0; e < 4; ++e) { sg[8 * h + e] = __builtin_amdgcn_exp2f(acc[ai][0][mp + h][0][e] * -LOG2E); sg[8 * h + 4 + e] = __builtin_amdgcn_exp2f(acc[ai][0][mp + h][1][e] * -LOG2E); }
#pragma unroll
                for (int e = 0; e < 16; ++e) sg[e] = 1.0f + sg[e];
#pragma unroll
                for (int e = 0; e < 16; ++e) sg[e] = __builtin_amdgcn_rcpf(sg[e]);
#pragma unroll
                for (int h = 0; h < 2; ++h) { f32x4 v0, v1;
#pragma unroll
                    for (int e = 0; e < 4; ++e) { v0[e] = acc[ai][0][mp + h][0][e] * sg[8 * h + e] * acc[ai][1][mp + h][0][e] * wr2[h]; v1[e] = acc[ai][0][mp + h][1][e] * sg[8 * h + 4 + e] * acc[ai][1][mp + h][1][e] * wr2[h]; }
                    p[h] = (u32x2){fp8x4(v0[0], v0[1], v0[2], v0[3]), fp8x4(v1[0], v1[1], v1[2], v1[3])}; }
                swap16_pair(p[0], p[1]);
                const int row = u.pm * 256 + rl0 + ai * 128 + (mp + (fq & 1)) * 16;
                *(u32x4*)(hmid + (size_t)row * 256 + cb) = (u32x4){p[0].x, p[0].y, p[1].x, p[1].y}; }
    }
};

struct EpiY8 { struct State {};
    unsigned char* Y; const LAS int* tile_nv;
    __device__ __forceinline__ void operator()(EPI_ARGS) const {
        const int rl0 = wr * 64 + fr + (fq & 1) * 16, row0 = u.pm * 256 + rl0; const int nv = tile_nv ? tile_nv[u.pm] : 256;
#pragma unroll
        for (int bj = 0; bj < 2; ++bj) {
            const int cb = u.pn * 256 + bj * 128 + wc * 32 + 16 * (fq >> 1);
#pragma unroll
            for (int ai = 0; ai < 2; ++ai)
#pragma unroll
                for (int mp = 0; mp < 4; mp += 2) { u32x2 p[2];
#pragma unroll
                    for (int h = 0; h < 2; ++h) { const f32x4 v0 = acc[ai][bj][mp + h][0] * Y8_SCALE, v1 = acc[ai][bj][mp + h][1] * Y8_SCALE;
                        p[h] = (u32x2){fp8x4(v0[0], v0[1], v0[2], v0[3]), fp8x4(v1[0], v1[1], v1[2], v1[3])}; }
                    swap16_pair(p[0], p[1]);
                    if (rl0 + ai * 128 + mp * 16 < nv) *(u32x4*)(Y + (size_t)(row0 + ai * 128 + mp * 16) * 1024 + cb) = (u32x4){p[0].x, p[0].y, p[1].x, p[1].y}; }
        }
    }
};

struct AttnSeg { const bf16_t* k; const bf16_t* vt; int ntiles; int kpos0; };
__device__ __forceinline__ float att_max3(float a, float b, float c) { return __builtin_fmaxf(__builtin_fmaxf(a, b), c); }
template <int DQK, bool BAND, bool SINK, bool QROPE, bool QSWA = false>
__device__ __forceinline__ void attn_unit(LAS unsigned char* lds, const bf16_t* qrow0, int qpitch, unsigned char* orow0, int opitch,
                                          AttnSeg s0, AttnSeg s1, int kpitch, int vpitch, int qpos0, float sink2, const float* tabm) {
    constexpr int NS = DQK / 16, KP = DQK * 2 + 16, VP = 136, KBUF = 64 * KP, VBUF = 64 * VP, CPR = DQK / 8, NCH = 64 * CPR;
    const int tid = threadIdx.x, lane = tid & 63, r = lane & 31, hh = lane >> 5;
    LAS unsigned char* Kb = lds; LAS unsigned char* Vb = lds + 2 * KBUF;
    bf16x8 qf[NS];
#pragma unroll
    for (int s = 0; s < NS; ++s) qf[s] = *(const bf16x8*)(qrow0 + (size_t)r * qpitch + 16 * s + 8 * hh);
    if (QROPE) {
        const int spos = (qpos0 + r) & 4095;
#pragma unroll
        for (int f = 4; f < 6; ++f) { const int pos = (f == 4) ? (spos >> 6) : (spos & 63); const float* cs = tabm + pos * 8; const float* sn = tabm + 512 + pos * 8;
            const u32x4 mine = __builtin_bit_cast(u32x4, qf[f]); u32x4 oth;
#pragma unroll
            for (int q = 0; q < 4; ++q) { auto rr = __builtin_amdgcn_permlane32_swap(mine[q], mine[q], false, false); oth[q] = hh ? rr[0] : rr[1]; }
            float a[8], b[8]; unpack8(mine, a); unpack8(oth, b);
#pragma unroll
            for (int e = 0; e < 8; ++e) a[e] = hh ? (a[e] * cs[e] + b[e] * sn[e]) : (a[e] * cs[e] - b[e] * sn[e]);
            qf[f] = __builtin_bit_cast(bf16x8, packf8(a)); }
    }
    if (QSWA) {
        const int spos = (qpos0 + r) & 4095;
#pragma unroll
        for (int f = 0; f < 4; f += 2) { float a[8], b[8]; unpack8(__builtin_bit_cast(u32x4, qf[f]), a); unpack8(__builtin_bit_cast(u32x4, qf[f + 1]), b);
            if (tabm != nullptr) { const int pos = (f == 0) ? (spos >> 6) : (spos & 63); const float* cs = tabm + pos * 16 + 8 * hh; const float* sn = tabm + 1024 + pos * 16 + 8 * hh;
#pragma unroll
                for (int e = 0; e < 8; ++e) { const float x = a[e] * cs[e] - b[e] * sn[e], y = b[e] * cs[e] + a[e] * sn[e]; a[e] = x; b[e] = y; } }
#pragma unroll
            for (int e = 0; e < 8; ++e) { a[e] *= SWA_QSCALE; b[e] *= SWA_QSCALE; }
            qf[f] = __builtin_bit_cast(bf16x8, packf8(a)); qf[f + 1] = __builtin_bit_cast(bf16x8, packf8(b)); }
    }
    const int ntot = s0.ntiles + s1.ntiles;
    const int kc0 = tid, kc1 = tid + 512;
    const int kr0 = kc0 / CPR, kq0 = kc0 % CPR, kr1 = kc1 / CPR, kq1 = kc1 % CPR;
    const bool k1ok = kc1 < NCH;
    const int vd = tid >> 3, vq = tid & 7;
    u32x4 kA0, kA1 = {0u, 0u, 0u, 0u}, vA, kB0, kB1 = {0u, 0u, 0u, 0u}, vB;
#define ATT_LOAD(it) do { const bool _s1 = (it) >= s0.ntiles; const int _j = _s1 ? (it) - s0.ntiles : (it); const bf16_t* _k = _s1 ? s1.k : s0.k; const bf16_t* _v = _s1 ? s1.vt : s0.vt; \
        kreg0 = *(const u32x4*)(_k + (size_t)(_j * 64 + kr0) * kpitch + kq0 * 8); \
        if (k1ok) kreg1 = *(const u32x4*)(_k + (size_t)(_j * 64 + kr1) * kpitch + kq1 * 8); \
        vreg = *(const u32x4*)(_v + (size_t)vd * vpitch + _j * 64 + vq * 8); } while (0)
#define ATT_STORE(buf) do { *(LAS u32x4*)(Kb + (buf) * KBUF + kr0 * KP + kq0 * 16) = kreg0; \
        if (k1ok) *(LAS u32x4*)(Kb + (buf) * KBUF + kr1 * KP + kq1 * 16) = kreg1; \
        LAS unsigned char* _vp = Vb + (buf) * VBUF + vd * VP + vq * 16; *(LAS u32x2*)_vp = (u32x2){vreg.x, vreg.y}; *(LAS u32x2*)(_vp + 8) = (u32x2){vreg.z, vreg.w}; } while (0)
    f32x16 ot0 = {}, ot1 = {};
#define ATT_KLOAD(kreg0, kreg1, it) do { const bool _s1 = (it) >= s0.ntiles; const int _j = _s1 ? (it) - s0.ntiles : (it); const bf16_t* _k = _s1 ? s1.k : s0.k; \
        kreg0 = *(const u32x4*)(_k + (size_t)(_j * 64 + kr0) * kpitch + kq0 * 8); \
        if (k1ok) kreg1 = *(const u32x4*)(_k + (size_t)(_j * 64 + kr1) * kpitch + kq1 * 8); } while (0)
#define ATT_VLOAD(vreg, it) do { const bool _s1 = (it) >= s0.ntiles; const int _j = _s1 ? (it) - s0.ntiles : (it); const bf16_t* _v = _s1 ? s1.vt : s0.vt; \
        vreg = *(const u32x4*)(_v + (size_t)vd * vpitch + _j * 64 + vq * 8); } while (0)
#define ATT_KSTORE(kreg0, kreg1, buf) do { *(LAS u32x4*)(Kb + (buf) * KBUF + kr0 * KP + kq0 * 16) = kreg0; \
        if (k1ok) *(LAS u32x4*)(Kb + (buf) * KBUF + kr1 * KP + kq1 * 16) = kreg1; } while (0)
#define ATT_VSTORE(vreg, buf) do { LAS unsigned char* _vp = Vb + (buf) * VBUF + vd * VP + vq * 16; *(LAS u32x2*)_vp = (u32x2){vreg.x, vreg.y}; *(LAS u32x2*)(_vp + 8) = (u32x2){vreg.z, vreg.w}; } while (0)
#define ATT_QK(dst0, dst1, buf, cinit) do { const LAS unsigned char* _kp = Kb + (buf) * KBUF + r * KP + hh * 16; \
        _Pragma("unroll") for (int s = 0; s < NS; ++s) { \
            const bf16x8 _k0 = *(const LAS bf16x8*)(_kp + s * 32), _k1 = *(const LAS bf16x8*)(_kp + 32 * KP + s * 32); \
            dst0 = __builtin_amdgcn_mfma_f32_32x32x16_bf16(_k0, qf[s], s == 0 ? cinit : dst0, 0, 0, 0); \
            dst1 = __builtin_amdgcn_mfma_f32_32x32x16_bf16(_k1, qf[s], s == 0 ? cinit : dst1, 0, 0, 0); } } while (0)
#define ATT_ROWMAX(C0, C1, mx) do { float _b; mx = att_max3(C0[0], C0[1], C1[0]); _b = att_max3(C0[2], C0[3], C1[1]); mx = att_max3(mx, C1[2], C1[3]); \
        _Pragma("unroll") for (int i = 4; i < 16; i += 4) { mx = att_max3(mx, C0[i], C0[i + 1]); _b = att_max3(_b, C0[i + 2], C0[i + 3]); mx = att_max3(mx, C1[i], C1[i + 1]); _b = att_max3(_b, C1[i + 2], C1[i + 3]); } \
        mx = fmaxf(mx, _b);     \
        { auto rr = __builtin_amdgcn_permlane32_swap(__float_as_uint(mx), __float_as_uint(mx), false, false); mx = fmaxf(__uint_as_float(rr[0]), __uint_as_float(rr[1])); } } while (0)
    ATT_KLOAD(kA0, kA1, 0); ATT_VLOAD(vA, 0); ATT_KLOAD(kB0, kB1, 1); ATT_KSTORE(kA0, kA1, 0); ATT_VSTORE(vA, 0); ATT_KSTORE(kB0, kB1, 1);
    ATT_KLOAD(kA0, kA1, 2); ATT_VLOAD(vA, 1);
    ATT_KLOAD(kB0, kB1, 3); ATT_VLOAD(vB, 2);
    __syncthreads();
    f32x16 sa0, sa1, sb0, sb1, ol = {}; const f32x16 negm = {};
    const bf16x8 ones = {0x3F80, 0x3F80, 0x3F80, 0x3F80, 0x3F80, 0x3F80, 0x3F80, 0x3F80};
    ATT_QK(sa0, sa1, 0, negm);
    float m_run, d_cur = 0.f;
    { ATT_ROWMAX(sa0, sa1, m_run);
#pragma unroll
      for (int i = 0; i < 16; ++i) { sa0[i] -= m_run; sa1[i] -= m_run; } }
    __syncthreads();
#define SBAR() __builtin_amdgcn_sched_barrier(0)
#define ATT_RM(C0, C1, i) do { if ((i) == 0) mx = att_max3(C0[0], C0[1], C1[0]); else if ((i) == 1) mb = att_max3(C0[2], C0[3], C1[1]); else if ((i) == 2) mx = att_max3(mx, C1[2], C1[3]); \
        else if ((i) < 15) { constexpr int _dummy = 0; const int _q = ((i) - 3) >> 2, _w = ((i) - 3) & 3, _b4 = 4 + 4 * _q; (void)_dummy; \
            if (_w == 0) mx = att_max3(mx, C0[_b4], C0[_b4 + 1]); else if (_w == 1) mb = att_max3(mb, C0[_b4 + 2], C0[_b4 + 3]); \
            else if (_w == 2) mx = att_max3(mx, C1[_b4], C1[_b4 + 1]); else mb = att_max3(mb, C1[_b4 + 2], C1[_b4 + 3]); } } while (0)
#define ATT_EXP4(C0, C1, g, h) do { _Pragma("unroll") for (int e = 0; e < 4; ++e) { if (((g) >> 1) == 0) C0[8 * ((g) & 1) + 4 * (h) + e] = __builtin_amdgcn_exp2f(C0[8 * ((g) & 1) + 4 * (h) + e]); \
        else C1[8 * ((g) & 1) + 4 * (h) + e] = __builtin_amdgcn_exp2f(C1[8 * ((g) & 1) + 4 * (h) + e]); } } while (0)
#define ATT_CVT4(C0, C1, g) do { const int _o = 8 * ((g) & 1); if (((g) >> 1) == 0) { pw[g].x = cvtpk(C0[_o + 0], C0[_o + 1]); pw[g].y = cvtpk(C0[_o + 2], C0[_o + 3]); pw[g].z = cvtpk(C0[_o + 4], C0[_o + 5]); pw[g].w = cvtpk(C0[_o + 6], C0[_o + 7]); } \
        else { pw[g].x = cvtpk(C1[_o + 0], C1[_o + 1]); pw[g].y = cvtpk(C1[_o + 2], C1[_o + 3]); pw[g].z = cvtpk(C1[_o + 4], C1[_o + 5]); pw[g].w = cvtpk(C1[_o + 6], C1[_o + 7]); } } while (0)
#define ATT_VFRAG(dst0_, dst1_, vp_, g) do { const int _ko = 32 * (g); \
        const s16x4 _a0l = *(const LAS s16x4*)((vp_) + _ko), _a0h = *(const LAS s16x4*)((vp_) + _ko + 16); \
        const s16x4 _a1l = *(const LAS s16x4*)((vp_) + 32 * VP + _ko), _a1h = *(const LAS s16x4*)((vp_) + 32 * VP + _ko + 16); \
        dst0_ = (bf16x8){_a0l[0], _a0l[1], _a0l[2], _a0l[3], _a0h[0], _a0h[1], _a0h[2], _a0h[3]}; \
        dst1_ = (bf16x8){_a1l[0], _a1l[1], _a1l[2], _a1l[3], _a1h[0], _a1h[1], _a1h[2], _a1h[3]}; } while (0)
#define ATT_STEP(C0, C1, N0, N1, it, buf, kr0_, kr1_, vr_) do { \
        const bool hasn = (it) + 1 < ntot; \
        if (BAND) { if ((it) >= s0.ntiles) { const int _kb = s1.kpos0 + ((it) - s0.ntiles) * 64 + 4 * hh - (qpos0 + r); \
            _Pragma("unroll") for (int i = 0; i < 16; ++i) { const int d0 = _kb + (i & 3) + 8 * (i >> 2), d1 = d0 + 32; \
                if (d0 > 128 || d0 < -128) C0[i] = -INFINITY; if (d1 > 128 || d1 < -128) C1[i] = -INFINITY; } } } \
        float mx = 0.f, mb = 0.f; \
        if (hasn) { const LAS unsigned char* _kp = Kb + ((buf) ^ 1) * KBUF + r * KP + hh * 16; const float _cv = -m_run; \
            _Pragma("unroll") for (int i = 0; i < 16; ++i) { N0[i] = _cv; N1[i] = _cv; } \
            bf16x8 _ka = *(const LAS bf16x8*)(_kp), _kb2 = *(const LAS bf16x8*)(_kp + 32 * KP); \
              \
            if ((it) + 2 < ntot) ATT_KSTORE(kr0_, kr1_, buf); ATT_VSTORE(vr_, (buf) ^ 1); \
            if ((it) + 4 < ntot) ATT_KLOAD(kr0_, kr1_, (it) + 4); if ((it) + 3 < ntot) ATT_VLOAD(vr_, (it) + 3); SBAR(); \
            _Pragma("unroll") for (int s = 0; s < NS; ++s) { bf16x8 _na = _ka, _nb = _kb2; \
                if (s + 1 < NS) { _na = *(const LAS bf16x8*)(_kp + (s + 1) * 32); _nb = *(const LAS bf16x8*)(_kp + 32 * KP + (s + 1) * 32); } \
                N0 = __builtin_amdgcn_mfma_f32_32x32x16_bf16(_ka, qf[s], N0, 0, 0, 0); ATT_RM(C0, C1, 3 * s); ATT_RM(C0, C1, 3 * s + 1); asm volatile("" : "+v"(mx), "+v"(mb)); SBAR(); \
                N1 = __builtin_amdgcn_mfma_f32_32x32x16_bf16(_kb2, qf[s], N1, 0, 0, 0); ATT_RM(C0, C1, 3 * s + 2); asm volatile("" : "+v"(mx), "+v"(mb)); SBAR(); \
                _ka = _na; _kb2 = _nb; } \
            _Pragma("unroll") for (int i = 3 * NS; i < 15; ++i) ATT_RM(C0, C1, i); \
        } else { _Pragma("unroll") for (int i = 0; i < 15; ++i) ATT_RM(C0, C1, i); } \
        mx = fmaxf(mx, mb); \
        { auto rr = __builtin_amdgcn_permlane32_swap(__float_as_uint(mx), __float_as_uint(mx), false, false); mx = fmaxf(__uint_as_float(rr[0]), __uint_as_float(rr[1])); } \
        float d_nxt = 0.f; \
        if (__any(mx > d_cur)) { const float dl = fmaxf(mx - d_cur, 0.f); const float alpha = __builtin_amdgcn_exp2f(-dl); m_run += dl; d_cur += dl; d_nxt = dl; \
            _Pragma("unroll") for (int i = 0; i < 16; ++i) { ot0[i] *= alpha; ot1[i] *= alpha; ol[i] *= alpha; } } \
        if (__any(d_cur != 0.f)) { _Pragma("unroll") for (int i = 0; i < 16; ++i) { C0[i] -= d_cur; C1[i] -= d_cur; } } \
        d_cur = d_nxt; \
        { const LAS unsigned char* _vp = Vb + (buf) * VBUF + r * VP + hh * 8; u32x4 pw[4]; bf16x8 _a0, _a1; \
          ATT_VFRAG(_a0, _a1, _vp, 0); ATT_EXP4(C0, C1, 0, 0); ATT_EXP4(C0, C1, 0, 1); ATT_CVT4(C0, C1, 0); SBAR(); \
          _Pragma("unroll") for (int g = 0; g < 4; ++g) { bf16x8 _n0 = _a0, _n1 = _a1; const bf16x8 pb = __builtin_bit_cast(bf16x8, pw[g]); \
            if (g + 1 < 4) ATT_VFRAG(_n0, _n1, _vp, g + 1); \
            ot0 = __builtin_amdgcn_mfma_f32_32x32x16_bf16(_a0, pb, ot0, 0, 0, 0); if (g + 1 < 4) ATT_EXP4(C0, C1, g + 1, 0); SBAR(); \
            ot1 = __builtin_amdgcn_mfma_f32_32x32x16_bf16(_a1, pb, ot1, 0, 0, 0); if (g + 1 < 4) ATT_EXP4(C0, C1, g + 1, 1); SBAR(); \
            ol = __builtin_amdgcn_mfma_f32_32x32x16_bf16(ones, pb, ol, 0, 0, 0); if (g + 1 < 4) ATT_CVT4(C0, C1, g + 1); SBAR(); \
            _a0 = _n0; _a1 = _n1; } } \
        __syncthreads(); } while (0)
    for (int it = 0; it < ntot; it += 2) {
        ATT_STEP(sa0, sa1, sb0, sb1, it, 0, kA0, kA1, vA);
        ATT_STEP(sb0, sb1, sa0, sa1, it + 1, 1, kB0, kB1, vB);
    }
#undef ATT_STEP
#undef ATT_RM
#undef ATT_EXP4
#undef ATT_CVT4
#undef ATT_VFRAG
#undef SBAR
#undef ATT_ROWMAX
#undef ATT_KLOAD
#undef ATT_VLOAD
#undef ATT_KSTORE
#undef ATT_VSTORE
#undef ATT_QK
#undef ATT_LOAD
#undef ATT_STORE
    float l_run = ol[0];
    if (SINK) { const float mnew = fmaxf(m_run, sink2); const float alpha = __builtin_amdgcn_exp2f(m_run - mnew);
        l_run = l_run * alpha + __builtin_amdgcn_exp2f(sink2 - mnew);
#pragma unroll
        for (int i = 0; i < 16; ++i) { ot0[i] *= alpha; ot1[i] *= alpha; } }
    const float inv = A8_SCALE / l_run;
    unsigned char* op = orow0 + (size_t)r * opitch + 4 * hh;
#pragma unroll
    for (int g = 0; g < 4; ++g) {
        *(unsigned*)(op + 8 * g) = fp8x4(ot0[4 * g] * inv, ot0[4 * g + 1] * inv, ot0[4 * g + 2] * inv, ot0[4 * g + 3] * inv);
        *(unsigned*)(op + 32 + 8 * g) = fp8x4(ot1[4 * g] * inv, ot1[4 * g + 1] * inv, ot1[4 * g + 2] * inv, ot1[4 * g + 3] * inv);
    }
}

struct Params {
    const float* in[29];
    float* out; unsigned char* ws;
    int ph_lo, ph_hi, use_bar, pad;
};
enum { I_X = 0, I_C, I_CTX, I_CCTX, I_WMOD, I_BMOD, I_GMIX, I_GFFN, I_WIN, I_GQ, I_GKV, I_WUQ, I_WUKV, I_WPOOL, I_PSCALE, I_SINK, I_WBRM, I_WBRP, I_WBRS, I_WOUT,
       I_WROUTER, I_RBIAS, I_WEG, I_WEU, I_WED, I_WSG, I_WSU, I_WSD, I_GFINAL };
constexpr int LDS_MISC = 131072;
constexpr int LDS_PTRS = LDS_MISC + 16;
constexpr int LDS_SCR = LDS_MISC + 512;
constexpr int LDS_BYTES = 131072 + 16384;
struct Frame {
    LAS unsigned char* lds; int tid, lane, wid, G, bid;
    unsigned char* ws; unsigned char* act;
    __device__ __forceinline__ const float* in(int i) const { const LAS unsigned* q = (const LAS unsigned*)(lds + LDS_PTRS) + 2 * i;
        const unsigned lo = __builtin_amdgcn_readfirstlane(q[0]), hi = __builtin_amdgcn_readfirstlane(q[1]); return (const float*)(const __attribute__((address_space(1))) float*)(((unsigned long long)hi << 32) | lo); }
    __device__ __forceinline__ float* outp() const { return (float*)in(29); }
    __device__ __forceinline__ float* mod(int l, int mr, int chunk) const { return (float*)(ws + WS_MOD) + ((size_t)(l * 5 + mr) * 6 + chunk) * 1024; }
    __device__ __forceinline__ unsigned char* wsm(int l) const { return ws + WS_WSM + (size_t)l * WSM_LAYER; }
};
constexpr int NTHREADS = 512;

struct ConvJob { const float* src; const float* rs; bf16_t* dst; int ldsrc, k0, n0, nvalid, lddst, drow0, lo, f8; float mul; };
__device__ __forceinline__ ConvJob mkjob(const float* src, int ldsrc, int k0, int n0, int nvalid, const float* rs, bf16_t* dst, int lddst, int drow0) {
    ConvJob j; j.src = src; j.rs = rs; j.dst = dst; j.ldsrc = ldsrc; j.k0 = k0; j.n0 = n0; j.nvalid = nvalid; j.lddst = lddst; j.drow0 = drow0; j.lo = 0; j.f8 = 0; j.mul = 1.0f; return j; }
struct ConvRegs { f32x4 v[4][2]; };
__device__ __forceinline__ void conv_load1(const Frame& F, const ConvJob& J, f32x4 (&v)[2]) {
    const int kp = F.tid >> 4, j4 = (F.tid & 15) * 4;
#pragma unroll
    for (int h = 0; h < 2; ++h) { f32x4 x = {0.f, 0.f, 0.f, 0.f};
        if (J.src != nullptr && J.n0 + j4 < J.nvalid) x = __builtin_nontemporal_load((const f32x4*)(J.src + (size_t)(J.k0 + 2 * kp + h) * J.ldsrc + J.n0 + j4));
        v[h] = x; }
}
__device__ __forceinline__ void conv_lds1(const Frame& F, const ConvJob& J, const f32x4 (&v)[2], int q) {
    const int kp = F.tid >> 4, j4 = (F.tid & 15) * 4;
    const float s0 = (J.rs ? J.rs[J.k0 + 2 * kp] : 1.0f) * J.mul, s1 = (J.rs ? J.rs[J.k0 + 2 * kp + 1] : 1.0f) * J.mul;
    LAS unsigned* t = (LAS unsigned*)F.lds + q * 64 * 33 + j4 * 33 + kp;
#pragma unroll
    for (int e = 0; e < 4; ++e) { float a0 = v[0][e] * s0, a1 = v[1][e] * s1;
        if (J.lo) { a0 -= bf2f(f2bf(a0)); a1 -= bf2f(f2bf(a1)); }
        t[e * 33] = J.f8 ? (unsigned)__builtin_amdgcn_cvt_pk_fp8_f32(a0, a1, 0, false) : cvtpk(a0, a1); }
}
__device__ __forceinline__ void conv_store1(const Frame& F, const ConvJob& J, int q) {
    const int j = F.tid >> 3, q8 = F.tid & 7;
    const LAS unsigned* t = (const LAS unsigned*)F.lds + q * 64 * 33 + j * 33 + 4 * q8;
    u32x4 w; w.x = t[0]; w.y = t[1]; w.z = t[2]; w.w = t[3];
    if (J.f8) { u32x2 b; b.x = (w.x & 0xffffu) | (w.y << 16); b.y = (w.z & 0xffffu) | (w.w << 16);
        *(u32x2*)((unsigned char*)J.dst + (size_t)(J.drow0 + j) * J.lddst + J.k0 + 8 * q8) = b; }
    else *(u32x4*)(J.dst + (size_t)(J.drow0 + j) * J.lddst + J.k0 + 8 * q8) = w;
}
__device__ __forceinline__ void conv_load4(const Frame& F, const ConvJob& J0, const ConvJob& J1, const ConvJob& J2, const ConvJob& J3, ConvRegs& R) {
    conv_load1(F, J0, R.v[0]); conv_load1(F, J1, R.v[1]); conv_load1(F, J2, R.v[2]); conv_load1(F, J3, R.v[3]); }
__device__ __forceinline__ void conv_finish4(const Frame& F, const ConvJob& J0, const ConvJob& J1, const ConvJob& J2, const ConvJob& J3, const ConvRegs& R) {
    conv_lds1(F, J0, R.v[0], 0); conv_lds1(F, J1, R.v[1], 1); conv_lds1(F, J2, R.v[2], 2); conv_lds1(F, J3, R.v[3], 3);
    __syncthreads();
    conv_store1(F, J0, 0); conv_store1(F, J1, 1); conv_store1(F, J2, 2); conv_store1(F, J3, 3);
    __syncthreads();
}
constexpr int CT_IN = 0, CT_G8 = 16 * 48, CT_I8 = 16 * 32, CT_UQ = 6 * 12, CT_UKV = 4 * 16, CT_BR = 8 * 16, CT_OUT = 16 * 16, CT_RS = 16 * 12, CT_SD = 4 * 16;
constexpr int CT_SMALL = CT_IN + CT_G8 + CT_I8 + CT_UQ + CT_UKV + 2 * CT_BR + CT_OUT + CT_RS + CT_SD;
static_assert(CT_SMALL % 4 == 0, "conversion jobs are taken four at a time");
__device__ __forceinline__ ConvJob conv_small_job(const Frame& F, int l, int id) {
    unsigned char* W = F.wsm(l);
    if (id < CT_IN) { const int kt = id / 32, nt = id % 32;
        return mkjob(F.in(I_WIN) + (size_t)l * 1024 * NIN, NIN, kt * 64, nt * 64, NIN, nullptr, (bf16_t*)(W + WO_IN), 1024, nt * 64); }
    id -= CT_IN;
    if (id < CT_G8) { const int kt = id / 48, j = id % 48;
        ConvJob cj = mkjob(F.in(I_WIN) + (size_t)l * 1024 * NIN, NIN, kt * 64, OFF_GL + 64 * j, NIN, nullptr, (bf16_t*)(W + WO_G8), 1024, 64 * j); cj.f8 = 1; cj.mul = -W8_SCALE * LOG2E; return cj; }
    id -= CT_G8;
    if (id < CT_I8) { const int kt = id / 32, nt = id % 32;
        ConvJob cj = mkjob(F.in(I_WIN) + (size_t)l * 1024 * NIN, NIN, kt * 64, nt * 64, NIN, nullptr, (bf16_t*)(W + WO_I8), 1024, nt * 64); cj.f8 = 1; cj.mul = W8_SCALE; return cj; }
    id -= CT_I8;
    if (id < CT_UQ) { const int kt = id / 12, nt = id % 12;
        ConvJob j = mkjob(F.in(I_WUQ) + (size_t)l * 384 * 768, 768, kt * 64, nt * 64, 768, F.in(I_GQ) + l * 384, (bf16_t*)(W + WO_UQ), 384, nt * 64); j.mul = MLA_QSCALE; return j; }
    id -= CT_UQ;
    if (id < CT_UKV) { const int kt = id / 16, nt = id % 16;
        return mkjob(F.in(I_WUKV) + (size_t)l * 256 * 1024, 1024, kt * 64, nt * 64, 1024, F.in(I_GKV) + l * 256, (bf16_t*)(W + ((nt & 1) ? WO_V : WO_K)), 256, (nt >> 1) * 64); }
    id -= CT_UKV;
    if (id < CT_BR) { const int kt = id / 16, nt = id % 16;
        ConvJob cj = mkjob(F.in(I_WBRM) + (size_t)l * 512 * 1024, 1024, kt * 64, nt * 64, 1024, nullptr, (bf16_t*)(W + WO_BRM), 512, nt * 64); cj.f8 = 1; cj.mul = W8_SCALE; return cj; }
    id -= CT_BR;
    if (id < CT_BR) { const int kt = id / 16, nt = id % 16;
        ConvJob cj = mkjob(F.in(I_WBRS) + (size_t)l * 512 * 1024, 1024, kt * 64, nt * 64, 1024, nullptr, (bf16_t*)(W + WO_BRS), 512, nt * 64); cj.f8 = 1; cj.mul = W8_SCALE; return cj; }
    id -= CT_BR;
    if (id < CT_OUT) { const int kt = id / 16, nt = id % 16;
        return mkjob(F.in(I_WOUT) + (size_t)l * 1024 * 1024, 1024, kt * 64, nt * 64, 1024, nullptr, (bf16_t*)(W + WO_OUT), 1024, nt * 64); }
    id -= CT_OUT;
    if (id < CT_RS) { const int kt = id / 12, rt = id % 12;
        const float* src = nullptr; int ld = 256, n0 = 0;
        if (rt < 8) { const int pn = rt >> 2, isup = (rt >> 1) & 1, sub = rt & 1; src = F.in(isup ? I_WSU : I_WSG) + (size_t)l * 1024 * 256; n0 = pn * 128 + sub * 64; }
        else if (rt == 8 || rt == 9) { src = F.in(I_WROUTER) + (size_t)l * 1024 * 64; ld = 64; n0 = 0; }
        ConvJob j = mkjob(src, ld, kt * 64, n0, ld, nullptr, (bf16_t*)(W + WO_RS), 1024, rt * 64); j.lo = (rt == 9) ? 1 : 0; return j; }
    id -= CT_RS;
    { const int kt = id / 16, nt = id % 16;
      return mkjob(F.in(I_WSD) + (size_t)l * 256 * 1024, 1024, kt * 64, nt * 64, 1024, nullptr, (bf16_t*)(W + WO_SD), 256, nt * 64); }
}
constexpr int CT_EXP = NEXP * 192;
__device__ __forceinline__ ConvJob conv_exp_job(const Frame& F, int l, int id) {
    const int e = id / 192, j = id % 192;
    if (j < 128) { const int isup = j >> 6, jj = j & 63, kt = jj >> 2, m = jj & 3;
        const float* src = F.in(isup ? I_WEU : I_WEG) + ((size_t)l * NEXP + e) * 1024 * 256;
        ConvJob cj = mkjob(src, 256, kt * 64, m * 64, 256, nullptr, (bf16_t*)(F.ws + WS_WGU + (size_t)e * 512 * 1024), 1024, (m >> 1) * 256 + isup * 128 + (m & 1) * 64);
        cj.f8 = 1; cj.mul = W8_SCALE; return cj;
    } else { const int jj = j - 128, kt = jj >> 4, nt = jj & 15;
        const float* src = F.in(I_WED) + ((size_t)l * NEXP + e) * 256 * 1024;
        ConvJob cj = mkjob(src, 1024, kt * 64, nt * 64, 1024, nullptr, (bf16_t*)(F.ws + WS_WDN + (size_t)e * 1024 * 256), 256, nt * 64);
        cj.f8 = 1; cj.mul = W8_SCALE; return cj; }
}
#define CONV_PIPE(NGROUPS, JOB, RANK, NWORK) do { int g = (RANK); if (g >= 0 && g < (NGROUPS)) { ConvRegs R; \
        { const int id = 4 * g; conv_load4(F, JOB(id), JOB(id + 1), JOB(id + 2), JOB(id + 3), R); } \
        for (;;) { const int gn = g + (NWORK); const bool more = gn < (NGROUPS); ConvRegs Rn; \
            if (more) { const int idn = 4 * gn; conv_load4(F, JOB(idn), JOB(idn + 1), JOB(idn + 2), JOB(idn + 3), Rn); } \
            { const int id = 4 * g; conv_finish4(F, JOB(id), JOB(id + 1), JOB(id + 2), JOB(id + 3), R); } \
            if (!more) break; R = Rn; g = gn; } } } while (0)
__device__ __forceinline__ void conv_small_all(const Frame& F, int l, int rank, int nwork) {
#define JOB_SMALL(id) conv_small_job(F, l, (id))
    CONV_PIPE(CT_SMALL / 4, JOB_SMALL, rank, nwork);
#undef JOB_SMALL
}
__device__ __forceinline__ void conv_exp_all(const Frame& F, int l, int rank, int nwork) {
#define JOB_EXP(id) conv_exp_job(F, l, (id))
    CONV_PIPE(CT_EXP / 4, JOB_EXP, rank, nwork);
#undef JOB_EXP
}
__device__ __forceinline__ void wcomb_job(const Frame& F, int l, int id) {
    const int j = id >> 4, n0 = (id & 15) * 64, tid = F.tid;
    LAS float* Pm = (LAS float*)F.lds;
    LAS float* Bm = Pm + 128 * 128;
    const float* wp = F.in(I_WPOOL) + ((size_t)l * 4 + j) * 128 * 128;
    const float* ps = F.in(I_PSCALE) + l * 512 + j * 128;
    const float* wb = F.in(I_WBRP) + ((size_t)l * 512 + j * 128) * 1024;
    for (int i = tid; i < 128 * 128; i += NTHREADS) Pm[i] = wp[i] * ps[i & 127];
    for (int i = tid; i < 128 * 64; i += NTHREADS) Bm[i] = wb[(size_t)(i >> 6) * 1024 + n0 + (i & 63)];
    __syncthreads();
    const int n = tid & 63, cg = tid >> 6;
    float a[16];
#pragma unroll
    for (int e = 0; e < 16; ++e) a[e] = 0.f;
    for (int d = 0; d < 128; ++d) { const float b = Bm[d * 64 + n];
#pragma unroll
        for (int e = 0; e < 16; ++e) a[e] = fmaf(Pm[(cg * 16 + e) * 128 + d], b, a[e]); }
    unsigned char* dst = F.wsm(l) + WO_COMB + (size_t)(n0 + n) * 512 + j * 128 + cg * 16;
#pragma unroll
    for (int e = 0; e < 16; ++e) a[e] *= W8_SCALE;
    *(u32x4*)dst = (u32x4){fp8x4(a[0], a[1], a[2], a[3]), fp8x4(a[4], a[5], a[6], a[7]), fp8x4(a[8], a[9], a[10], a[11]), fp8x4(a[12], a[13], a[14], a[15])};
    __syncthreads();
}
__device__ __forceinline__ void mod_job(const Frame& F, int id) {
    const int l = id / 96, n0 = (id % 96) * 64, tid = F.tid, n4 = tid & 15, kq = tid >> 4;
    const float* wm = F.in(I_WMOD) + (size_t)l * 1024 * 6144 + n0 + 4 * n4;
    LAS float* S = (LAS float*)F.lds;
    LAS float* R = S + 5 * 1024;
    for (int i = tid; i < 5 * 1024; i += NTHREADS) { const int r = i >> 10, k = i & 1023; const float cv = (r < 4) ? F.in(I_C)[r * 1024 + k] : F.in(I_CCTX)[k]; S[i] = cv * fast_sigmoid(cv); }
    __syncthreads();
    f32x4 a[5];
#pragma unroll
    for (int r = 0; r < 5; ++r) a[r] = (f32x4){0.f, 0.f, 0.f, 0.f};
    for (int kb = kq * 32; kb < kq * 32 + 32; kb += 16) {
        f32x4 w[16];
#pragma unroll
        for (int u = 0; u < 16; ++u) w[u] = __builtin_nontemporal_load((const f32x4*)(wm + (size_t)(kb + u) * 6144));
#pragma unroll
        for (int u = 0; u < 16; ++u) {
#pragma unroll
            for (int r = 0; r < 5; ++r) a[r] += w[u] * S[r * 1024 + kb + u]; }
    }
#pragma unroll
    for (int r = 0; r < 5; ++r) *(LAS f32x4*)(R + (kq * 5 + r) * 64 + 4 * n4) = a[r];
    __syncthreads();
    if (tid < 320) { const int r = tid >> 6, n = tid & 63; float sacc = 0.f;
#pragma unroll
        for (int g = 0; g < 32; ++g) sacc += R[(g * 5 + r) * 64 + n];
        const int col = n0 + n;
        ((float*)(F.ws + WS_MOD))[(size_t)(l * 5 + r) * 6144 + col] = sacc + F.in(I_BMOD)[l * 6144 + col]; }
    __syncthreads();
}
__device__ __forceinline__ void tab_job(const Frame& F) {
    float* tm = (float*)(F.ws + WS_TABM); float* ts = (float*)(F.ws + WS_TABS);
    for (int i = F.tid; i < 64 * 8 + 64 * 16; i += NTHREADS) {
        const bool mla = i < 512; const int ii = mla ? i : i - 512, nf = mla ? 8 : 16, pos = ii / nf, fi = ii % nf;
        const float invf = exp2f(-(float)fi / (float)nf * 13.287712379549449f);
        float s, c; sincos_small((float)pos * invf, s, c);
        float* tb = mla ? tm : ts; tb[pos * nf + fi] = c; tb[64 * nf + pos * nf + fi] = s;
    }
}
constexpr int P0_MOD = 192, P0_TAB = 1, P0_WCOMB = 2 * 64;
constexpr int P0_ITEMS = P0_MOD + P0_TAB + P0_WCOMB;
__device__ __forceinline__ void setup_layer(const Frame& F, int l, int rank, int nwork) {
    if (rank < 0) return;
    constexpr int NIT = P0_MOD / 2 + P0_WCOMB / 2 + 1;
    for (int it = nwork - 1 - rank; it < NIT; it += nwork) {
        int id = it;
        if (id < P0_MOD / 2) { mod_job(F, l * (P0_MOD / 2) + id); continue; } id -= P0_MOD / 2;
        if (id < P0_WCOMB / 2) { wcomb_job(F, l, id); continue; }
        if (l == 0) tab_job(F);
    }
    conv_small_all(F, l, rank, nwork);
}
__device__ __forceinline__ void phase_p0(const Frame& F) { setup_layer(F, 0, F.bid, F.G); }

struct RouteTabs { const LAS int* off; const LAS int* tile_e; const LAS int* tile_base; const LAS int* tile_nv; int ntiles; };
__device__ __forceinline__ RouteTabs route_tables(const Frame& F, int l, bool tiles) {
    LAS int* cn = (LAS int*)(F.lds + LDS_SCR); LAS int* off = cn + 64; LAS int* te = cn + 192; LAS int* tb = te + MAXTILES; LAS int* tn = tb + MAXTILES;
    const unsigned* cnt = (const unsigned*)(F.ws + WS_CTL) + CW_CNT + l * 64;
    __syncthreads();
    if (F.tid < 64) cn[F.tid] = (int)ld_ctl(cnt + F.tid);
    __syncthreads();
    if (F.tid == 0) { int o = 0; for (int e = 0; e < 64; ++e) { off[e] = o; o += (cn[e] + 255) & ~255; } off[64] = o; }
    __syncthreads();
    RouteTabs r; r.off = off; r.tile_e = te; r.tile_base = tb; r.tile_nv = tn; r.ntiles = off[64] >> 8;
    if (tiles) { for (int tl = F.tid; tl < r.ntiles; tl += NTHREADS) { int e = 0; for (int q = 1; q < 64; ++q) e += (off[q] <= tl * 256) ? 1 : 0;
                     const int first = tl * 256 - off[e]; te[tl] = e; tb[tl] = e * TT + first; tn[tl] = cn[e] - first; }
                 __syncthreads(); }
    return r;
}

__device__ __forceinline__ const float* xin_row(const Frame& F, int l, int t) {
    (void)l;
    return t < TL ? F.in(I_X) + (size_t)t * 1024 : F.in(I_CTX) + (size_t)(t - TL) * 1024;
}
__device__ __forceinline__ unsigned dpp_xor1(unsigned x) { return (unsigned)__builtin_amdgcn_update_dpp(0, (int)x, 0xB1, 0xF, 0xF, true); }
__device__ __forceinline__ void store_pair_b16(bf16_t* row, int i0, int i1, const u32x2& w0, const u32x2& w1, int lane) {
    const bool odd = lane & 1; const u32x2 snd = odd ? w0 : w1; const u32x2 rcv = (u32x2){dpp_xor1(snd.x), dpp_xor1(snd.y)};
    const u32x4 o = odd ? (u32x4){rcv.x, rcv.y, w1.x, w1.y} : (u32x4){w0.x, w0.y, rcv.x, rcv.y};
    *(u32x4*)(row + 256 * (odd ? i1 : i0) + 4 * (lane & ~1)) = o; }
__device__ __forceinline__ void store_pair_b8(unsigned char* row, int i0, int i1, unsigned w0, unsigned w1, int lane) {
    const bool odd = lane & 1; const unsigned rcv = dpp_xor1(odd ? w0 : w1);
    const u32x2 o = odd ? (u32x2){rcv, w1} : (u32x2){w0, rcv};
    *(u32x2*)(row + 256 * (odd ? i1 : i0) + 4 * (lane & ~1)) = o; }
__device__ __forceinline__ void norm_mod_store(const f32x4 (&v)[4], const float* g, const float* sc, const float* sh, bf16_t* dst, int lane, unsigned char* dst8 = nullptr) {
    float ss = 0.f;
#pragma unroll
    for (int i = 0; i < 4; ++i) ss += v[i][0] * v[i][0] + v[i][1] * v[i][1] + v[i][2] * v[i][2] + v[i][3] * v[i][3];
    ss = wave_sum(ss);
    const float rstd = rsqrtf(ss * (1.0f / 1024.0f) + NORM_EPS);
    u32x2 wb[4]; unsigned w8[4];
#pragma unroll
    for (int i = 0; i < 4; ++i) { const int c = 4 * lane + 256 * i;
        const f32x4 gv = *(const f32x4*)(g + c), sv = *(const f32x4*)(sc + c), hv = *(const f32x4*)(sh + c);
        f32x4 o;
#pragma unroll
        for (int e = 0; e < 4; ++e) o[e] = v[i][e] * rstd * gv[e] * (1.0f + sv[e]) + hv[e];
        wb[i].x = cvtpk(o[0], o[1]); wb[i].y = cvtpk(o[2], o[3]);
        { int q = 0; q = __builtin_amdgcn_cvt_pk_fp8_f32(o[0] * F8_SCALE, o[1] * F8_SCALE, q, false); q = __builtin_amdgcn_cvt_pk_fp8_f32(o[2] * F8_SCALE, o[3] * F8_SCALE, q, true); w8[i] = (unsigned)q; } }
    if (dst)  { store_pair_b16(dst, 0, 1, wb[0], wb[1], lane); store_pair_b16(dst, 2, 3, wb[2], wb[3], lane); }
    if (dst8) { store_pair_b8(dst8, 0, 1, w8[0], w8[1], lane); store_pair_b8(dst8, 2, 3, w8[2], w8[3], lane); }
}
__device__ __forceinline__ void phase_e1(const Frame& F) {
    const float* g = F.in(I_GMIX);
    for (int t = F.bid * 8 + F.wid; t < TT; t += F.G * 8) {
        const float* xr = xin_row(F, 0, t); f32x4 v[4];
#pragma unroll
        for (int i = 0; i < 4; ++i) v[i] = __builtin_nontemporal_load((const f32x4*)(xr + 4 * F.lane + 256 * i));
        const int mr = tok_modrow(t);
        norm_mod_store(v, g, F.mod(0, mr, 1), F.mod(0, mr, 0), nullptr, F.lane, F.ws + WS_H8 + (size_t)t * 1024);
    }
}
__device__ __forceinline__ void phase_e5(const Frame& F, int l, int Te) {
    const float* g = F.in(I_GFFN) + l * 1024;
    bf16_t* Fb = (bf16_t*)(F.act + A_F);
    unsigned char* F8 = F.act + A_F8;
    if (F.bid == 0) { for (int i = F.tid; i < 512; i += NTHREADS) ((unsigned*)(Fb + (size_t)TT * 1024))[i] = 0u;
        for (int i = F.tid; i < 256; i += NTHREADS) ((unsigned*)(F8 + (size_t)TT * 1024))[i] = 0u; }
    for (int t = F.bid * 8 + F.wid; t < Te; t += F.G * 8) {
        const int mr = tok_modrow(t); const bf16_t* xr = (const bf16_t*)(F.ws + WS_X) + (size_t)t * 1024; f32x4 v[4];
#pragma unroll
        for (int i = 0; i < 4; ++i) { const u32x2 xw = *(const u32x2*)(xr + 4 * F.lane + 256 * i); v[i] = (f32x4){bflo(xw.x), bfhi(xw.x), bflo(xw.y), bfhi(xw.y)}; }
        norm_mod_store(v, g, F.mod(l, mr, 4), F.mod(l, mr, 3), Fb + (size_t)t * 1024, F.lane, F8 + (size_t)t * 1024);
    }
}
__device__ __forceinline__ void phase_e6(const Frame& F, int l, int Te) {
    const unsigned char* Y = F.act + A_YH0; const unsigned char* YS = F.act + A_YS;
    const int* toke = (const int*)(F.ws + WS_TOKE); const int* tokp = (const int*)(F.ws + WS_TOKP); const RouteTabs rt = route_tables(F, l, false);
    const bool last = (l == DEPTH - 1);
    for (int t = F.bid * 8 + F.wid; t < Te; t += F.G * 8) {
        const int c = 16 * F.lane; const int mr = tok_modrow(t);
        bf16_t* xo = (bf16_t*)(F.ws + WS_X) + (size_t)t * 1024 + c;
        float a[16];
#pragma unroll
        for (int i = 0; i < 16; ++i) a[i] = 0.f;
#pragma unroll
        for (int k = 0; k < 8; ++k) { const int rw = rt.off[toke[t * 8 + k]] + tokp[t * 8 + k]; const u32x4 w = *(const u32x4*)(Y + (size_t)rw * 1024 + c);
#pragma unroll
            for (int q = 0; q < 4; ++q) { const f32x2v lo = __builtin_amdgcn_cvt_pk_f32_fp8((int)w[q], false), hi = __builtin_amdgcn_cvt_pk_f32_fp8((int)w[q], true);
                a[4 * q] += lo.x; a[4 * q + 1] += lo.y; a[4 * q + 2] += hi.x; a[4 * q + 3] += hi.y; } }
        { const u32x4 w = *(const u32x4*)(YS + (size_t)t * 1024 + c);
#pragma unroll
          for (int q = 0; q < 4; ++q) { const f32x2v lo = __builtin_amdgcn_cvt_pk_f32_fp8((int)w[q], false), hi = __builtin_amdgcn_cvt_pk_f32_fp8((int)w[q], true);
              a[4 * q] += lo.x; a[4 * q + 1] += lo.y; a[4 * q + 2] += hi.x; a[4 * q + 3] += hi.y; }
#pragma unroll
          for (int i = 0; i < 16; ++i) a[i] *= (1.0f / Y8_SCALE); }
        const float* gt = F.mod(l, mr, 5) + c;
        float x[16]; float ss = 0.f;
        { float xin[16]; unpack8(*(const u32x4*)xo, *(float(*)[8])&xin[0]); unpack8(*(const u32x4*)(xo + 8), *(float(*)[8])&xin[8]);
#pragma unroll
          for (int q = 0; q < 4; ++q) { const f32x4 gv = *(const f32x4*)(gt + 4 * q);
#pragma unroll
            for (int e = 0; e < 4; ++e) { x[4 * q + e] = xin[4 * q + e] + gv[e] * a[4 * q + e]; ss += x[4 * q + e] * x[4 * q + e]; } } }
        ss = wave_sum(ss);
        const float rstd = rsqrtf(ss * (1.0f / 1024.0f) + NORM_EPS);
        if (last) {
            if (t < TL) { const float* gf = F.in(I_GFINAL) + c; float* o = F.outp() + (size_t)t * 1024 + c;
#pragma unroll
                for (int q = 0; q < 4; ++q) { const f32x4 gv = *(const f32x4*)(gf + 4 * q); f32x4 ov;
#pragma unroll
                    for (int e = 0; e < 4; ++e) ov[e] = x[4 * q + e] * rstd * gv[e];
                    *(f32x4*)(o + 4 * q) = ov; } }
        } else {
            *(u32x4*)xo = packf8(*(const float(*)[8])&x[0]); *(u32x4*)(xo + 8) = packf8(*(const float(*)[8])&x[8]);
            const float* g = F.in(I_GMIX) + (l + 1) * 1024 + c; const float* sc = F.mod(l + 1, mr, 1) + c; const float* sh = F.mod(l + 1, mr, 0) + c;
            float o[16];
#pragma unroll
            for (int q = 0; q < 4; ++q) { const f32x4 gv = *(const f32x4*)(g + 4 * q), sv = *(const f32x4*)(sc + 4 * q), hv = *(const f32x4*)(sh + 4 * q);
#pragma unroll
                for (int e = 0; e < 4; ++e) o[4 * q + e] = x[4 * q + e] * rstd * gv[e] * (1.0f + sv[e]) + hv[e]; }
            { u32x4 w8;
#pragma unroll
              for (int q = 0; q < 4; ++q) { int w = 0; w = __builtin_amdgcn_cvt_pk_fp8_f32(o[4 * q] * F8_SCALE, o[4 * q + 1] * F8_SCALE, w, false); w = __builtin_amdgcn_cvt_pk_fp8_f32(o[4 * q + 2] * F8_SCALE, o[4 * q + 3] * F8_SCALE, w, true); w8[q] = (unsigned)w; }
              *(u32x4*)(F.ws + WS_H8 + (size_t)t * 1024 + c) = w8; }
        }
    }
}
__device__ __forceinline__ void rope8(float (&mine)[8], const float (&oth)[8], const float* cs, const float* sn, bool first) {
#pragma unroll
    for (int e = 0; e < 8; ++e) mine[e] = first ? (mine[e] * cs[e] - oth[e] * sn[e]) : (mine[e] * cs[e] + oth[e] * sn[e]);
}
__device__ __forceinline__ void phase_e3(const Frame& F) {
    const bf16_t* CQ = (const bf16_t*)(F.act + A_CQ); const bf16_t* CKV = (const bf16_t*)(F.act + A_CKV); const bf16_t* KR = (const bf16_t*)(F.act + A_KR);
    const bf16_t* U = (const bf16_t*)(F.act + A_U); const bf16_t* QSR = (const bf16_t*)(F.act + A_QSR); const bf16_t* KSR = (const bf16_t*)(F.act + A_KSR);
    bf16_t* CQN = (bf16_t*)(F.act + A_CQN); bf16_t* CKVN = (bf16_t*)(F.act + A_CKVN); unsigned char* POOL = F.act + A_POOL;
    bf16_t* QS = (bf16_t*)(F.act + A_QS); bf16_t* KS = (bf16_t*)(F.act + A_KS); bf16_t* KK = (bf16_t*)(F.act + A_K);
    const float* tabm = (const float*)(F.ws + WS_TABM); const float* tabs = (const float*)(F.ws + WS_TABS);
    const int lane = F.lane;
    for (int t = F.bid * 8 + F.wid; t < TT; t += F.G * 8) {
        const bool lat = t < TL; const int s = lat ? (t & 4095) : ((t - TL) & 255); const int L = lat ? SEQ : CTXL;
        const int prow = s >> 6, pcol = s & 63;
        const int kh = (lane & 31) >> 2, kq = lane & 3; const bf16_t* kr = KR + (size_t)t * 32;
        const u32x4 krm = *(const u32x4*)(kr + 8 * kq), kro = *(const u32x4*)(kr + 8 * (kq ^ 1));
        const int w = 2 << (lane >> 4); int lo = s - (w >> 1), hi = s + (w >> 1); lo = lo < 0 ? 0 : lo; hi = hi > L ? L : hi;
        const bf16_t* ub = U + (size_t)(t - s) * 512 + 8 * lane;
        u32x4 uw[16];
#pragma unroll
        for (int k = 0; k < 16; ++k) { const int q = lo + k; uw[k] = *(const u32x4*)(ub + (size_t)(q < hi ? q : s) * 512); }
        const u32x4 ume = *(const u32x4*)(ub + (size_t)s * 512);
        const int kl = lane & 15;
        const u32x4 ka = *(const u32x4*)(KSR + (size_t)t * 128 + 8 * kl), kb = *(const u32x4*)(KSR + (size_t)t * 128 + 8 * (kl ^ 2));
        { float a[8], b[8]; unpack8(krm, a); unpack8(kro, b);
          if (lat) { const int pos = (kq < 2) ? prow : pcol; rope8(a, b, tabm + pos * 8, tabm + 512 + pos * 8, (kq & 1) == 0); }
          if (lane < 32) *(u32x4*)(KK + (size_t)t * 768 + kh * 96 + 64 + 8 * kq) = packf8(a); }
        { float acc[8] = {0.f, 0.f, 0.f, 0.f, 0.f, 0.f, 0.f, 0.f};
#pragma unroll
          for (int k = 0; k < 16; ++k) { float a[8]; unpack8(uw[k], a); const float on = (lo + k < hi) ? 1.0f : 0.0f;
#pragma unroll
              for (int e = 0; e < 8; ++e) acc[e] = fmaf(a[e], on, acc[e]); }
          float me[8]; unpack8(ume, me);
          const float inv = 1.0f / (float)(hi - lo);
#pragma unroll
          for (int e = 0; e < 8; ++e) acc[e] = (acc[e] * inv - me[e]) * A8_SCALE;
          *(u32x2*)(POOL + (size_t)t * 512 + 8 * lane) = (u32x2){fp8x4(acc[0], acc[1], acc[2], acc[3]), fp8x4(acc[4], acc[5], acc[6], acc[7])}; }
        { float a[8], b[8]; unpack8(ka, a); unpack8(kb, b);
          if (lat) { const int qt = (kl & 7) >> 1, i0 = (kl & 1) * 8; const int pos = (qt < 2) ? prow : pcol;
              rope8(a, b, tabs + pos * 16 + i0, tabs + 1024 + pos * 16 + i0, (qt & 1) == 0); }
          if (lane < 16) *(u32x4*)(KS + (size_t)t * 128 + 8 * lane) = packf8(a); }
    }
}
__device__ __forceinline__ void phase_att(const Frame& F, int l) {
    const bool last = (l == DEPTH - 1);
    const bf16_t* Q = (const bf16_t*)(F.act + A_Q); const bf16_t* K = (const bf16_t*)(F.act + A_K); const bf16_t* VT = (const bf16_t*)(F.act + A_VT);
    const bf16_t* QS = (const bf16_t*)(F.act + A_QS); const bf16_t* KS = (const bf16_t*)(F.act + A_KS); const bf16_t* VST = (const bf16_t*)(F.act + A_VST);
    unsigned char* YM = F.act + A_YMLA; unsigned char* YW = F.act + A_YSWA;
    const int wid = F.wid;
    const int nper = F.G / 8;
    for (int v = F.bid / 8; v < 64; v += nper) {
        const int x = F.bid & 7, bh = x * 4 + (v >> 4), qb = v & 15, b = bh >> 3, h = bh & 7;
        const int row0 = b * SEQ + qb * 256 + 32 * wid;
        AttnSeg s0, s1;
        s0.k = K + (size_t)(TL + b * CTXL) * 768 + h * 96; s0.vt = VT + (size_t)(h * 64) * TT + TL + b * CTXL; s0.ntiles = 4; s0.kpos0 = 0;
        s1.k = K + (size_t)(b * SEQ) * 768 + h * 96;       s1.vt = VT + (size_t)(h * 64) * TT + b * SEQ;       s1.ntiles = 64; s1.kpos0 = 0;
        attn_unit<96, false, false, true>(F.lds, Q + (size_t)row0 * 768 + h * 96, 768, YM + (size_t)row0 * 512 + h * 64, 512, s0, s1, 768, TT, qb * 256 + 32 * wid, 0.f, (const float*)(F.ws + WS_TABM));
    }
    for (int u = F.bid; u < 512; u += F.G) {
        const int pair = u & 1, n = (u >> 1) & 31, kvh = (u >> 6) & 1, b = u >> 7;
        const int head = kvh * 4 + pair * 2 + (wid >> 2), tq = n * 128 + 32 * (wid & 3), row0 = b * SEQ + tq;
        const int nb0 = n > 0 ? n - 1 : 0, nb1 = n < 31 ? n + 1 : 31;
        AttnSeg s0, s1;
        s0.k = KS + (size_t)(TL + b * CTXL) * 128 + kvh * 64; s0.vt = VST + (size_t)(kvh * 64) * TT + TL + b * CTXL; s0.ntiles = 4; s0.kpos0 = 0;
        s1.k = KS + (size_t)(b * SEQ + nb0 * 128) * 128 + kvh * 64; s1.vt = VST + (size_t)(kvh * 64) * TT + b * SEQ + nb0 * 128; s1.ntiles = 2 * (nb1 - nb0 + 1); s1.kpos0 = nb0 * 128;
        const float sink2 = F.in(I_SINK)[l * 8 + head] * LOG2E;
        attn_unit<64, true, true, false, true>(F.lds, QS + (size_t)row0 * 512 + head * 64, 512, YW + (size_t)row0 * 512 + head * 64, 512, s0, s1, 128, TT, tq, sink2, (const float*)(F.ws + WS_TABS));
    }
    if (!last) {
        AttnSeg s1; s1.k = nullptr; s1.vt = nullptr; s1.ntiles = 0; s1.kpos0 = 0;
        for (int u = F.bid; u < 32; u += F.G) {
            const int b = u >> 3, h = u & 7, row0 = TL + b * CTXL + 32 * wid;
            AttnSeg s0; s0.k = K + (size_t)(TL + b * CTXL) * 768 + h * 96; s0.vt = VT + (size_t)(h * 64) * TT + TL + b * CTXL; s0.ntiles = 4; s0.kpos0 = 0;
            attn_unit<96, false, false, false>(F.lds, Q + (size_t)row0 * 768 + h * 96, 768, YM + (size_t)row0 * 512 + h * 64, 512, s0, s1, 768, TT, 0, 0.f, nullptr);
        }
        for (int u = F.G - 1 - F.bid; u < 32; u += F.G) {
            const int b = u >> 3, head = u & 7, kvh = head >> 2, row0 = TL + b * CTXL + 32 * wid;
            AttnSeg s0; s0.k = KS + (size_t)(TL + b * CTXL) * 128 + kvh * 64; s0.vt = VST + (size_t)(kvh * 64) * TT + TL + b * CTXL; s0.ntiles = 4; s0.kpos0 = 0;
            const float sink2 = F.in(I_SINK)[l * 8 + head] * LOG2E;
            attn_unit<64, false, true, false, true>(F.lds, QS + (size_t)row0 * 512 + head * 64, 512, YW + (size_t)row0 * 512 + head * 64, 512, s0, s1, 128, TT, 0, sink2, nullptr);
        }
    }
}

__device__ __forceinline__ float rdlane_f(float v, int l) { return __int_as_float(__builtin_amdgcn_readlane(__float_as_int(v), l)); }
__device__ __forceinline__ void phase_r1(const Frame& F, int l, int Te) {
    LAS unsigned char* sb = F.lds + LDS_SCR;
    LAS int* lcount = (LAS int*)sb; LAS int* lbase = lcount + 64; LAS int* se = lbase + 64;
    const int TPB = (Te + F.G - 1) / F.G;
    LAS int* sp = se + 80 * 8; LAS float* sw = (LAS float*)(sp + 80 * 8);
    const float* logits = (const float*)(F.ws + WS_LOGIT); const float* logits2 = (const float*)(F.ws + WS_LOGIT2);
    unsigned* cnt = (unsigned*)(F.ws + WS_CTL) + CW_CNT + l * 64;
    const int lane = F.lane, g = lane >> 3;
    if (F.tid < 64) lcount[F.tid] = 0;
    __syncthreads();
    const int t0 = F.bid * TPB;
    const float bias = F.in(I_RBIAS)[l * 64 + lane];
    for (int ti = F.wid; ti < TPB; ti += 8) {
        const int t = t0 + ti; if (t >= Te) break;
        const float score = 1.0f / (1.0f + expf(-(logits[(size_t)t * 64 + lane] + logits2[(size_t)t * 64 + lane])));
        const float selv = score + bias;
        float m1 = selv; m1 = fmaxf(m1, __shfl_xor(m1, 1)); m1 = fmaxf(m1, __shfl_xor(m1, 2)); m1 = fmaxf(m1, __shfl_xor(m1, 4));
        const unsigned long long eq = __ballot(selv == m1);
        const int first = __builtin_ctz((unsigned)((eq >> (g * 8)) & 0xffull));
        float m2 = ((lane & 7) == first) ? -INFINITY : selv; m2 = fmaxf(m2, __shfl_xor(m2, 1)); m2 = fmaxf(m2, __shfl_xor(m2, 2)); m2 = fmaxf(m2, __shfl_xor(m2, 4));
        const float gs = m1 + m2;
        int grank = 0;
#pragma unroll
        for (int g2 = 0; g2 < 8; ++g2) { const float o = rdlane_f(gs, g2 * 8); grank += (o > gs || (o == gs && g2 < g)) ? 1 : 0; }
        const bool gsel = grank < 4;
        const float ms = gsel ? selv : -INFINITY;
        int rnk = 0;
#pragma unroll
        for (int e2 = 0; e2 < 64; ++e2) { const float o = rdlane_f(ms, e2); rnk += (o > ms || (o == ms && e2 < lane)) ? 1 : 0; }
        const bool chosen = gsel && rnk < 8;
        const float wsum = wave_sum(chosen ? score : 0.f);
        if (chosen) { const int lp = atomicAdd((int*)&lcount[lane], 1);
            se[ti * 8 + rnk] = lane; sp[ti * 8 + rnk] = lp; sw[ti * 8 + rnk] = score / wsum * 2.5f; }
    }
    __syncthreads();
    if (F.tid < 64) lbase[F.tid] = (int)xb_add(cnt + F.tid, (unsigned)lcount[F.tid]);
    __syncthreads();
    int* toke = (int*)(F.ws + WS_TOKE); int* tokp = (int*)(F.ws + WS_TOKP); int* ptok = (int*)(F.ws + WS_PTOK); float* pwt = (float*)(F.ws + WS_PWT);
    for (int i = F.tid; i < TPB * 8; i += NTHREADS) { const int t = t0 + (i >> 3); if (t >= Te) break;
        const int e = se[i], pos = lbase[e] + sp[i]; toke[(size_t)t * 8 + (i & 7)] = e; tokp[(size_t)t * 8 + (i & 7)] = pos;
        ptok[(size_t)e * TT + pos] = t; pwt[(size_t)e * TT + pos] = sw[i]; }
    __syncthreads();
}
__device__ __forceinline__ pg8::Dense dense(const Frame& F, const void* A, const void* Bt, int M, int N, int K, int rot) {
    pg8::Dense d; d.A = (const bf16_t*)A; d.Bt = (const bf16_t*)Bt; d.nM = M / 256; d.nN = N / 256; d.K = K; d.G = F.G; d.c = (F.bid + F.G - (rot % F.G)) % F.G; return d;
}
__device__ __forceinline__ void phase_g1(const Frame& F, int l) {
    unsigned char* W = F.wsm(l);
    { EpiGate8 E; E.gates = F.act + A_GATES;
      pg8::DenseT<true, 0x7A7A7A7A, 0x7A7A7A7A> d; d.A = (const bf16_t*)(F.ws + WS_H8); d.Bt = (const bf16_t*)(W + WO_G8); d.nM = TT / 256; d.nN = 3072 / 256; d.K = 512; d.G = F.G; d.c = F.bid;
      pg8::gemm_phase(F.lds, d, E); }
    { EpiSeg E; E.act = F.act;
      pg8::DenseT<true, 0x7A7A7A7A, 0x7A7A7A7A> d; d.A = (const bf16_t*)(F.ws + WS_H8); d.Bt = (const bf16_t*)(W + WO_I8); d.nM = TT / 256; d.nN = 8; d.K = 512; d.G = F.G; d.c = (F.bid + F.G - 48) % F.G;
      pg8::gemm_phase(F.lds, d, E); }
    { EpiStore E; E.O = (bf16_t*)(F.act + A_VST); E.ldo = TT; E.lgin = 20; E.gout = 0; E.mrows = 256;
      pg8::DenseT<true, 0x7A7A7A7A, 0x7A7A7A7A> d; d.A = (const bf16_t*)(W + WO_I8 + (size_t)OFF_VS * 1024); d.Bt = (const bf16_t*)(F.ws + WS_H8); d.nM = 1; d.nN = TT / 256; d.K = 512; d.G = F.G; d.c = (F.bid + F.G - 80) % F.G;
      pg8::gemm_phase(F.lds, d, E); }
}
__device__ __forceinline__ void phase_g2(const Frame& F, int l) {
    unsigned char* W = F.wsm(l);
    LAS float* tab = (LAS float*)(F.lds + LDS_SCR);
    { EpiStoreRS<384> E; E.O = (bf16_t*)(F.act + A_Q); E.ldo = 768; E.lgin = 20; E.gout = 0; E.src = (const bf16_t*)(F.act + A_CQ); E.tab = tab;
      pg8::gemm_phase(F.lds, dense(F, F.act + A_CQ, W + WO_UQ, TT, 768, 384, 0), E); }
    { EpiStoreRS<256> E; E.O = (bf16_t*)(F.act + A_K); E.ldo = 768; E.lgin = 6; E.gout = 96; E.src = (const bf16_t*)(F.act + A_CKV); E.tab = tab;
      pg8::gemm_phase(F.lds, dense(F, F.act + A_CKV, W + WO_K, TT, 512, 256, 208), E); }
    { EpiStoreCS E; E.O = (bf16_t*)(F.act + A_VT); E.ldo = TT; E.src = (const bf16_t*)(F.act + A_CKV); E.tab = tab;
      pg8::gemm_phase(F.lds, dense(F, W + WO_V, F.act + A_CKV, 512, TT, 256, 88), E); }
}
__device__ __forceinline__ void phase_g4(const Frame& F, int l, int Mr) {
    unsigned char* W = F.wsm(l);
    pg8::Merge3HT<true, 0x79797979, 0x79797979> P;
    P.A0 = (const bf16_t*)(F.act + A_YMLA); P.A1 = (const bf16_t*)(F.act + A_POOL); P.A2 = (const bf16_t*)(F.act + A_YSWA);
    P.B0 = (const bf16_t*)(W + WO_BRM); P.B1 = (const bf16_t*)(W + WO_COMB); P.B2 = (const bf16_t*)(W + WO_BRS); P.nM = Mr / 256; P.nN = 8; P.K = 256; P.G = F.G; P.c = F.bid;
    EpiMerge3H E; E.out = (bf16_t*)(F.act + A_H); E.gates = F.act + A_GATES;
    pg8::gemm_phase(F.lds, P, E);
}
__device__ __forceinline__ void phase_g5(const Frame& F, int l, int Mr) {
    EpiResid E; E.X = (bf16_t*)(F.ws + WS_X); E.xlat = (l == 0) ? F.in(I_X) : nullptr; E.xctx = (l == 0) ? F.in(I_CTX) : nullptr; E.mod2 = F.mod(l, 0, 2);
    pg8::gemm_phase(F.lds, dense(F, F.act + A_H, F.wsm(l) + WO_OUT, Mr, 1024, 1024, 0), E);
}
__device__ __forceinline__ void phase_g6(const Frame& F, int l, int Mr) {
    EpiG6 E; E.hs = (bf16_t*)(F.act + A_HS); E.logits = (float*)(F.ws + WS_LOGIT); E.logits2 = (float*)(F.ws + WS_LOGIT2); E.mrows = Mr;
    pg8::gemm_phase(F.lds, dense(F, F.act + A_F, F.wsm(l) + WO_RS, Mr, 768, 1024, 0), E);
}
__device__ __forceinline__ void phase_g7(const Frame& F, int l, int Mr) {
    pg8::Grouped<true, true, 0x7A7A7A7A, 0x7A7A7A7A> P;
    P.A = (const bf16_t*)(F.act + A_F8); P.W = (const bf16_t*)(F.ws + WS_WGU); P.estride = (size_t)512 * 512; P.ncol0 = 0;
    const RouteTabs rt = route_tables(F, l, true); P.ntiles = rt.ntiles; P.tile_e = rt.tile_e; P.tile_base = rt.tile_base; P.tile_nv = rt.tile_nv; P.ptok = (const int*)(F.ws + WS_PTOK); P.nN = 2; P.K = 512; P.G = F.G; P.c = F.bid;
    EpiG7 E; E.hmid = F.act + A_HMID; E.pwt = (const float*)(F.ws + WS_PWT); E.tile_base = rt.tile_base; E.tile_nv = rt.tile_nv;
    pg8::gemm_phase(F.lds, P, E);
    { const int rem = (P.ntiles * 2) % F.G; int nw = F.G - rem, rank = F.bid - rem;
      if (rem == 0 || nw < 64) { nw = F.G; rank = F.bid; }
      if (rank >= 0) { EpiY8 E2; E2.Y = F.act + A_YS; E2.tile_nv = nullptr; pg8::Dense d = dense(F, F.act + A_HS, F.wsm(l) + WO_SD, Mr, 1024, 256, 0); d.G = nw; d.c = rank; pg8::gemm_phase(F.lds, d, E2); } }
}
__device__ __forceinline__ void phase_g8(const Frame& F, int l, int Mr) {
    pg8::Grouped<false, true, 0x79797979, 0x79797979> P;
    P.A = (const bf16_t*)(F.act + A_HMID); P.W = (const bf16_t*)(F.ws + WS_WDN); P.estride = (size_t)1024 * 128; P.ncol0 = 0;
    const RouteTabs rt = route_tables(F, l, true); P.ntiles = rt.ntiles; P.tile_e = rt.tile_e; P.tile_base = rt.tile_base; P.tile_nv = rt.tile_nv; P.ptok = nullptr; P.nN = 4; P.K = 128; P.G = F.G; P.c = F.bid;
    EpiY8 E; E.Y = F.act + A_YH0; E.tile_nv = rt.tile_nv;
    pg8::gemm_phase(F.lds, P, E);
}

constexpr int NPH_LAYER = 11, NPHASE = 2 + DEPTH * NPH_LAYER;
__global__ void __launch_bounds__(NTHREADS) __attribute__((amdgpu_waves_per_eu(2, 2))) fwd_kernel(Params p) {
    extern __shared__ __attribute__((aligned(16))) unsigned char lds_raw[];
    Frame F; F.lds = (LAS unsigned char*)lds_raw; F.tid = threadIdx.x; F.lane = F.tid & 63; F.wid = __builtin_amdgcn_readfirstlane(F.tid >> 6);
    F.G = gridDim.x; F.bid = blockIdx.x; F.ws = p.ws; F.act = p.ws + WS_ACT;
    volatile LAS unsigned* bw = (volatile LAS unsigned*)(F.lds + LDS_MISC);
    if (F.tid < 4) bw[F.tid] = 0u;
    if (F.tid == 0) { LAS unsigned* q = (LAS unsigned*)(F.lds + LDS_PTRS);
#pragma unroll
        for (int i = 0; i < 30; ++i) { const unsigned long long v = (i < 29) ? (unsigned long long)p.in[i < 29 ? i : 0] : (unsigned long long)p.out; q[2 * i] = (unsigned)v; q[2 * i + 1] = (unsigned)(v >> 32); } }
    __syncthreads();
    XcdBarrier bar; bar.bar = (unsigned*)(p.ws + WS_CTL) + CW_BAR; bar.x = 0; bar.st = bw;
    if (p.use_bar) bar = xcd_barrier_post((unsigned*)(p.ws + WS_CTL) + CW_BAR, bw);
    int ph = 0;
#ifndef PH_ONLY
#define PH_ONLY -1
#endif
#define RUNX(idx, body) do { if (ph >= p.ph_lo && ph < p.ph_hi) { if (PH_ONLY < 0 || PH_ONLY == (idx)) { unsigned long long wsl = (unsigned long long)p.ws; asm volatile("" : "+s"(wsl)); F.ws = (unsigned char*)(__attribute__((address_space(1))) unsigned char*)wsl; F.act = F.ws + WS_ACT; body; } if (p.use_bar && ph + 1 < p.ph_hi) xcd_barrier(bar); } ++ph; } while (0)
    RUNX(0, phase_p0(F));
    RUNX(1, phase_e1(F));
#define LAYER(l) do { \
        const bool last = (l == DEPTH - 1); \
        const int Te = last ? TL : TT; \
        RUNX(2, { phase_g1(F, l); if (l == 0) { const int busy = (TT / 256) * (NINP / 256) + TT / 256 - 5 * F.G;     \
            if (busy > 0 && busy < F.G) setup_layer(F, 1, F.bid - busy, F.G - busy); else setup_layer(F, 1, F.bid, F.G); } }); \
          \
        RUNX(3, { if (F.bid & 1) phase_g2(F, l); phase_e3(F); if (!(F.bid & 1)) phase_g2(F, l); }); \
        RUNX(6, phase_att(F, l)); \
        RUNX(7, { phase_g4(F, l, Te); if (l == 0) { const int extra = (Te / 256) * 8 - 2 * F.G;   \
            if (extra > 0 && extra < F.G) conv_exp_all(F, 0, F.bid - extra, F.G - extra); else conv_exp_all(F, 0, F.bid, F.G); } }); \
        RUNX(8, phase_g5(F, l, Te)); \
        RUNX(9, phase_e5(F, l, Te)); \
        RUNX(10, phase_g6(F, l, Te)); \
        RUNX(11, phase_r1(F, l, Te)); \
        RUNX(13, phase_g7(F, l, Te)); \
        RUNX(14, phase_g8(F, l, Te)); \
        RUNX(15, { phase_e6(F, l, Te); if (!last) conv_exp_all(F, l + 1, F.bid, F.G); }); \
    } while (0)
    LAYER(0);
    LAYER(1);
#undef LAYER
#undef RUNX
}

extern "C" void kernel_launch(void* const* d_in, const int* in_sizes, int n_in, void* d_out, int out_size, void* d_ws, size_t ws_size, hipStream_t stream) {
    static int grid = 0;
    if (grid == 0) {
        if (n_in != 29 || out_size != TL * DM || ws_size < WS_END) {
            fprintf(stderr, "kernel_launch: expected 29 inputs, %d outputs, >= %zu bytes of workspace; got n_in %d, out %d, ws %zu; nothing launched\n", TL * DM, (size_t)WS_END, n_in, out_size, ws_size);
            grid = -1; return; }
        int dev = 0, cus = 0, per_cu = 0;
        if (hipGetDevice(&dev) != hipSuccess || hipDeviceGetAttribute(&cus, hipDeviceAttributeMultiprocessorCount, dev) != hipSuccess) { grid = -1; return; }
        if (hipFuncSetAttribute((const void*)fwd_kernel, hipFuncAttributeMaxDynamicSharedMemorySize, LDS_BYTES) != hipSuccess) { fprintf(stderr, "kernel_launch: hipFuncSetAttribute failed\n"); grid = -1; return; }
        if (hipOccupancyMaxActiveBlocksPerMultiprocessor(&per_cu, (const void*)fwd_kernel, NTHREADS, LDS_BYTES) != hipSuccess || per_cu < 1) {
            fprintf(stderr, "kernel_launch: occupancy query reports %d workgroups per CU\n", per_cu); (void)hipGetLastError(); }
        grid = cus < 256 ? cus : 256;
        if (grid != 256) fprintf(stderr, "kernel_launch: %d CUs; this build is laid out for 256\n", cus);
    }
    if (grid < 0) return;
    if (hipMemsetAsync((char*)d_ws + WS_CTL, 0, CTL_BYTES, stream) != hipSuccess) return;
    Params p{};
    for (int i = 0; i < 29; ++i) p.in[i] = (const float*)d_in[i];
    p.out = (float*)d_out; p.ws = (unsigned char*)d_ws; p.pad = 0;
#if KL_LAUNCH_MODE == 1
    p.ph_lo = 0; p.ph_hi = NPHASE; p.use_bar = 1;
    hipLaunchKernelGGL(fwd_kernel, dim3(grid), dim3(NTHREADS), LDS_BYTES, stream, p);
#else
    p.use_bar = 0;
    for (int i = 0; i < NPHASE; ++i) { p.ph_lo = i; p.ph_hi = i + 1; hipLaunchKernelGGL(fwd_kernel, dim3(grid), dim3(NTHREADS), LDS_BYTES, stream, p); }
#endif
}
```

```cpp
#include <hip/hip_runtime.h>
#include <cstdio>
#include <cstdint>

#ifndef KL_LAUNCH_MODE
#define KL_LAUNCH_MODE 1
#endif

#define LAS __attribute__((address_space(3)))
typedef unsigned short bf16_t;
typedef short bf16x8 __attribute__((ext_vector_type(8)));
typedef short s16x4 __attribute__((ext_vector_type(4)));
typedef float f32x4 __attribute__((ext_vector_type(4)));
typedef float f32x16 __attribute__((ext_vector_type(16)));
typedef unsigned u32x4 __attribute__((ext_vector_type(4)));
typedef int i32x4 __attribute__((ext_vector_type(4)));
typedef int i32x8 __attribute__((ext_vector_type(8)));
typedef unsigned u32x2 __attribute__((ext_vector_type(2)));
typedef float f32x2_t __attribute__((ext_vector_type(2)));
typedef __bf16 bf16x2_t __attribute__((ext_vector_type(2)));

constexpr int DM = 1024, NB = 4, SEQ = 4096, CTXL = 256, DEPTH = 2;
constexpr int TL = NB * SEQ;
constexpr int TC = NB * CTXL;
constexpr int TT = TL + TC;
constexpr int NIN = 5024, NINP = 5120;
constexpr int OFF_CQ = 0, OFF_CKV = 384, OFF_KR = 640, OFF_U = 672, OFF_QS = 1184, OFF_KS = 1696, OFF_VS = 1824, OFF_GL = 1952;
constexpr int NEXP = 64, TOPK = 8, DEXP = 256;
constexpr int MAXROWS = 155648;
constexpr int MAXTILES = MAXROWS / 256;
constexpr float NORM_EPS = 1e-6f;
constexpr float LOG2E = 1.4426950408889634f;
constexpr float MLA_QSCALE = 0.10206207261596577f * LOG2E;
constexpr float SWA_QSCALE = 0.125f * LOG2E;

constexpr size_t al256(size_t x) { return (x + 255) & ~(size_t)255; }
constexpr size_t WS_CTL = 0;
constexpr size_t CTL_BYTES = 65536;
constexpr int CW_BAR = 0;
constexpr int CW_CNT = 4096;
constexpr size_t WS_MOD = WS_CTL + CTL_BYTES;
constexpr size_t WS_TABM = WS_MOD + al256((size_t)DEPTH * 5 * 6144 * 4);
constexpr size_t WS_TABS = WS_TABM + 4096;
constexpr size_t WS_MISC = WS_TABS + 8192;
constexpr size_t WS_TILEE = WS_MISC + 256;
constexpr size_t WS_WSM = WS_TILEE + al256(MAXTILES * 4);
constexpr size_t WO_IN = 0;
constexpr size_t WO_UQ = WO_IN + (size_t)NINP * 1024 * 2;
constexpr size_t WO_K = WO_UQ + (size_t)768 * 384 * 2;
constexpr size_t WO_V = WO_K + (size_t)512 * 256 * 2;
constexpr size_t WO_COMB = WO_V + (size_t)512 * 256 * 2;
constexpr size_t WO_BRM = WO_COMB + (size_t)1024 * 512 * 2;
constexpr size_t WO_BRS = WO_BRM + (size_t)1024 * 512 * 2;
constexpr size_t WO_OUT = WO_BRS + (size_t)1024 * 512 * 2;
constexpr size_t WO_RS = WO_OUT + (size_t)1024 * 1024 * 2;
constexpr size_t WO_SD = WO_RS + (size_t)768 * 1024 * 2;
constexpr size_t WO_G8 = WO_SD + (size_t)1024 * 256 * 2;
constexpr size_t WO_I8 = WO_G8 + (size_t)3072 * 1024;
constexpr size_t WSM_LAYER = WO_I8 + (size_t)(2048 + 64) * 1024;
constexpr size_t WS_WGU = WS_WSM + DEPTH * WSM_LAYER;
constexpr size_t WS_WDN = WS_WGU + (size_t)NEXP * 512 * 1024 * 2;
constexpr size_t WS_X = WS_WDN + (size_t)NEXP * 1024 * 256 * 2;
constexpr size_t WS_H8 = WS_X + (size_t)TT * 1024 * 2;
constexpr size_t WS_PTOK = WS_X + (size_t)TT * 1024 * 3;
constexpr size_t WS_PWT = WS_PTOK + (size_t)NEXP * TT * 4;
constexpr size_t WS_LOGIT = WS_X + (size_t)TT * 1024 * 4;
static_assert(WS_PWT + (size_t)NEXP * TT * 4 + 4096 <= WS_LOGIT, "expert lists do not fit");
constexpr size_t WS_LOGIT2 = WS_LOGIT + (size_t)TT * 64 * 4;
constexpr size_t WS_TOKE = WS_LOGIT2 + (size_t)TT * 64 * 4;
constexpr size_t WS_TOKP = WS_TOKE + (size_t)TT * 8 * 4;
constexpr size_t WS_TOKW = WS_TOKP + (size_t)TT * 8 * 4;
constexpr size_t WS_TOKR = WS_TOKW + (size_t)TT * 8 * 4;
constexpr size_t WS_ROWT = WS_TOKR + (size_t)TT * 8 * 4;
constexpr size_t WS_ROWW = WS_ROWT + (size_t)MAXROWS * 4;
constexpr size_t WS_ACT = al256(WS_ROWW + (size_t)MAXROWS * 4);
constexpr size_t A_H = 0;
constexpr size_t A_SEG = A_H + (size_t)TT * 1024 * 2;
constexpr size_t A_CQ = A_SEG;
constexpr size_t A_CKV = A_CQ + (size_t)TT * 384 * 2;
constexpr size_t A_KR = A_CKV + (size_t)TT * 256 * 2;
constexpr size_t A_U = A_KR + (size_t)TT * 32 * 2;
constexpr size_t A_QSR = A_U + (size_t)TT * 512 * 2;
constexpr size_t A_KSR = A_QSR + (size_t)TT * 512 * 2;
constexpr size_t A_SEGEND = A_KSR + (size_t)TT * 128 * 2;
constexpr size_t A_QRAW = A_SEG;
constexpr size_t A_Q = A_H;
constexpr size_t A_YO = A_SEG;
constexpr size_t A_GATES = A_SEGEND;
constexpr size_t A_F = A_GATES;
constexpr size_t A_HS = A_F + al256((size_t)(TT + 1) * 1024 * 2);
constexpr size_t A_YS = A_HS + (size_t)TT * 256 * 2;
constexpr size_t A_F8 = A_YS + (size_t)TT * 1024 * 2;
constexpr size_t A_YH0 = A_YS + (size_t)TT * 1024 * 2;
constexpr size_t A_CQN = A_GATES + (size_t)TT * 3072 * 2;
constexpr size_t A_CKVN = A_CQN + (size_t)TT * 384 * 2;
constexpr size_t A_POOL = A_CKVN + (size_t)TT * 256 * 2;
constexpr size_t A_QS = A_POOL + (size_t)TT * 512 * 2;
constexpr size_t A_KS = A_QS + (size_t)TT * 512 * 2;
constexpr size_t A_VST = A_KS + (size_t)TT * 128 * 2;
constexpr size_t A_K = A_VST + (size_t)256 * TT * 2;
constexpr size_t A_VT = A_K + (size_t)TT * 768 * 2;
constexpr size_t A_YMLA = A_VT + (size_t)512 * TT * 2;
constexpr size_t A_YSWA = A_YMLA + (size_t)TT * 512 * 2;
constexpr size_t A_END = A_YSWA + (size_t)TT * 512 * 2;
constexpr size_t A_HMID = A_H;
static_assert(A_HMID + (size_t)MAXROWS * 256 * 2 <= A_GATES, "hmid overlaps f");
static_assert(A_YH0 + (size_t)MAXROWS * 512 * 2 <= A_END, "Y half does not fit");
static_assert(A_Q + (size_t)TT * 768 * 2 <= A_SEG, "Q does not fit");
constexpr size_t WS_END = WS_ACT + A_END;

#define XB_TMO      128
#define XB_XCNT(j)  (256  + 64 * (j))
#define XB_XSUB(j)  (1280 + 64 * (j))
#define XB_XGEN(j)  (2304 + 64 * (j))
#define XB_TOP      3328
#define XB_TOPGEN   3392
#define XCD_BAR_WORDS 3456
#define XB_SPIN_CAP (1u << 18)
__device__ __forceinline__ unsigned xb_ld(unsigned* p)              { return __hip_atomic_load(p, __ATOMIC_RELAXED, __HIP_MEMORY_SCOPE_AGENT); }
__device__ __forceinline__ unsigned xb_add(unsigned* p, unsigned v) { return __hip_atomic_fetch_add(p, v, __ATOMIC_RELAXED, __HIP_MEMORY_SCOPE_AGENT); }
__device__ __forceinline__ unsigned xb_xcc_id() { return (unsigned)__builtin_amdgcn_s_getreg((3 << 11) | 20) & 0xFu; }
#define XB_SPIN(cond, bar) do { unsigned _sp = 0; while (cond) { __builtin_amdgcn_s_sleep(1); \
    if ((++_sp & 255u) == 0u) { if (xb_ld(&(bar)[XB_TMO])) break; if (_sp > XB_SPIN_CAP) { atomicAdd(&(bar)[XB_TMO], 1u); break; } } } } while (0)
struct XcdBarrier { unsigned* bar; unsigned x; volatile LAS unsigned* st; };
__device__ __forceinline__ XcdBarrier xcd_barrier_post(unsigned* bar, volatile LAS unsigned* st) {
    XcdBarrier b; b.bar = bar; b.x = xb_xcc_id(); b.st = st;
    if (threadIdx.x == 0) (void)xb_add(&bar[XB_XCNT(b.x)], 1u);
    return b;
}
__device__ __forceinline__ void xcd_barrier_complete(unsigned* bar, unsigned x, unsigned& nloc, unsigned& nx) {
    const unsigned G = gridDim.x * gridDim.y * gridDim.z;
    unsigned sum, cnt, mine, sp = 0u;
    for (;;) {
        sum = 0u; cnt = 0u; mine = 0u;
#pragma unroll
        for (unsigned j = 0; j < 16; ++j) { const unsigned c = xb_ld(&bar[XB_XCNT(j)]); sum += c; cnt += (c > 0u) ? 1u : 0u; mine = (j == x) ? c : mine; }
        if (sum == G) break;
        __builtin_amdgcn_s_sleep(1);
        if ((++sp & 255u) == 0u) { if (xb_ld(&bar[XB_TMO])) break; if (sp > XB_SPIN_CAP) { atomicAdd(&bar[XB_TMO], 1u); break; } }
    }
    nloc = mine > 0u ? mine : 1u; nx = cnt > 0u ? cnt : 1u;
}
__device__ __forceinline__ void xcd_barrier(const XcdBarrier& b) {
    asm volatile("s_waitcnt vmcnt(0)" ::: "memory");
    __syncthreads();
    if (threadIdx.x == 0) {
        unsigned* bar = b.bar;
        __builtin_amdgcn_s_waitcnt(0);
        unsigned nloc = b.st[0], nx = b.st[1];
        if (nloc == 0u) { xcd_barrier_complete(bar, b.x, nloc, nx); b.st[0] = nloc; b.st[1] = nx; }
        const unsigned old = xb_add(&bar[XB_XSUB(b.x)], 1u);
        const unsigned gen = old / nloc;
        if (old + 1u == (gen + 1u) * nloc) {
            __builtin_amdgcn_fence(__ATOMIC_RELEASE, "agent");
            asm volatile("s_waitcnt vmcnt(0)" ::: "memory");
            const unsigned og = xb_add(&bar[XB_TOP], 1u);
            const unsigned tg = og / nx;
            if (og + 1u == (tg + 1u) * nx) xb_add(&bar[XB_TOPGEN], 1u);
            else XB_SPIN(xb_ld(&bar[XB_TOPGEN]) == tg, bar);
            __builtin_amdgcn_fence(__ATOMIC_ACQUIRE, "agent");
            xb_add(&bar[XB_XGEN(b.x)], 1u);
            asm volatile("s_waitcnt vmcnt(0)" ::: "memory");
        } else {
            XB_SPIN(xb_ld(&bar[XB_XGEN(b.x)]) == gen, bar);
            __builtin_amdgcn_fence(__ATOMIC_ACQUIRE, "agent");
            asm volatile("s_waitcnt vmcnt(0)" ::: "memory");
        }
    }
    __syncthreads();
}

__device__ __forceinline__ unsigned cvtpk(float lo, float hi) { f32x2_t v = {lo, hi}; bf16x2_t b = __builtin_convertvector(v, bf16x2_t); return __builtin_bit_cast(unsigned, b); }
__device__ __forceinline__ bf16_t f2bf(float f) { return (bf16_t)(cvtpk(f, 0.f) & 0xffffu); }
__device__ __forceinline__ float bflo(unsigned w) { return __uint_as_float(w << 16); }
__device__ __forceinline__ float bfhi(unsigned w) { return __uint_as_float(w & 0xffff0000u); }
__device__ __forceinline__ float bf2f(bf16_t b) { return __uint_as_float(((unsigned)b) << 16); }
__device__ __forceinline__ void unpack8(const u32x4& w, float (&a)[8]) { a[0] = bflo(w.x); a[1] = bfhi(w.x); a[2] = bflo(w.y); a[3] = bfhi(w.y); a[4] = bflo(w.z); a[5] = bfhi(w.z); a[6] = bflo(w.w); a[7] = bfhi(w.w); }
__device__ __forceinline__ u32x4 packf8(const float (&a)[8]) { u32x4 w; w.x = cvtpk(a[0], a[1]); w.y = cvtpk(a[2], a[3]); w.z = cvtpk(a[4], a[5]); w.w = cvtpk(a[6], a[7]); return w; }
__device__ __forceinline__ float fast_sigmoid(float x) { return __builtin_amdgcn_rcpf(1.0f + __builtin_amdgcn_exp2f(-x * LOG2E)); }
__device__ __forceinline__ float fast_silu(float x) { return x * fast_sigmoid(x); }
__device__ __forceinline__ unsigned fp8x4(float a, float b, float c, float d) { int w = 0; w = __builtin_amdgcn_cvt_pk_fp8_f32(a, b, w, false); w = __builtin_amdgcn_cvt_pk_fp8_f32(c, d, w, true); return (unsigned)w; }
__device__ __forceinline__ float sat448(float x) { return __builtin_amdgcn_fmed3f(x, 448.0f, -448.0f); }
__device__ __forceinline__ unsigned fp8x4s(float a, float b, float c, float d) { return fp8x4(sat448(a), sat448(b), sat448(c), sat448(d)); }
constexpr float A8_SCALE = 32.0f;
__device__ __forceinline__ float wave_sum(float v) {
#pragma unroll
    for (int o = 32; o > 0; o >>= 1) v += __shfl_xor(v, o);
    return v;
}
__device__ __forceinline__ unsigned ld_ctl(const unsigned* p) { return __hip_atomic_load(p, __ATOMIC_RELAXED, __HIP_MEMORY_SCOPE_AGENT); }
__device__ __forceinline__ int ld_ctl(const int* p) { return __hip_atomic_load(p, __ATOMIC_RELAXED, __HIP_MEMORY_SCOPE_AGENT); }
__device__ __forceinline__ void sincos_small(float a, float& s, float& c) {
    const float k = rintf(a * 0.63661977236758134f);
    float r = fmaf(k, -1.57079637050628662109375f, a);
    r = fmaf(k, 4.37113900018624283e-8f, r);
    const float r2 = r * r;
    const float sr = r + r * r2 * (-1.6666667163e-1f + r2 * (8.3333337680e-3f + r2 * (-1.9841270114e-4f + r2 * 2.7557314297e-6f)));
    const float cr = 1.0f + r2 * (-0.5f + r2 * (4.1666667908e-2f + r2 * (-1.3888889225e-3f + r2 * (2.4801587642e-5f - r2 * 2.7557314297e-7f))));
    const int q = ((int)k) & 3;
    s = (q == 0) ? sr : (q == 1) ? cr : (q == 2) ? -sr : -cr;
    c = (q == 0) ? cr : (q == 1) ? -sr : (q == 2) ? -cr : sr;
}
__device__ __forceinline__ int tok_modrow(int t) { return t < TL ? (t >> 12) : 4; }

namespace pg8 {
constexpr int BM = 256, BK = 64, HALF = 128, HTB = HALF * BK * 2, STAGE_BYTES = 8 * HTB, NXCD = 8, WGM = 8;
__host__ __device__ __forceinline__ int lds_byte(int r, int c) { const int st = (r >> 4) * 2 + (c >> 5), rr = r & 15, cc = c & 31, ob = rr * 64 + cc * 2; return st * 1024 + (ob ^ (((ob >> 9) & 1) << 5)); }
__host__ __device__ __forceinline__ void stage_rc(int b, int& R, int& C) { const int st = b / 1024, sb = b % 1024, swz = sb ^ (((sb >> 9) & 1) << 5); R = (st >> 1) * 16 + swz / 64; C = (st & 1) * 32 + (swz % 64) / 2; }
__host__ __device__ __forceinline__ int perm32(int rho) { const int n = rho >> 4, i = rho & 15; return 8 * (i >> 2) + 4 * n + (i & 3); }
struct Unit { int pm, pn, br; };
__device__ __forceinline__ bool static_next(int nM, int nN, int G, int c, int i, Unit& u) {
    const int nwg = nM * nN; const long L = (long)i * G + c; if (L >= nwg) return false;
    int wgid = (int)L; { const int q = nwg / NXCD, r = nwg % NXCD, xcd = wgid % NXCD, off = wgid / NXCD; wgid = (xcd < r ? xcd * (q + 1) : r * (q + 1) + (xcd - r) * q) + off; }
    const int nig = WGM * nN, gid = wgid / nig, fm = gid * WGM, gsz = (nM - fm) < WGM ? (nM - fm) : WGM;
    u.pm = fm + ((wgid % nig) % gsz); u.pn = (wgid % nig) / gsz; return true;
}
template <bool F8 = false, int SW_ = 0, int SX_ = 0> struct DenseT {
    static constexpr bool GATHER = false, FP8 = F8, HALFN = false; static constexpr int SW = SW_, SX = SX_;
    const bf16_t* A; const bf16_t* Bt; int nM, nN, K, G, c;
    __device__ __forceinline__ bool next(int i, Unit& u) const { return static_next(nM, nN, G, c, i, u); }
    __device__ __forceinline__ const char* a_base(const Unit& u) const { return (const char*)A + (size_t)u.pm * 256 * K * 2; }
    __device__ __forceinline__ const char* b_base(const Unit& u) const { return (const char*)Bt + (size_t)u.pn * 256 * K * 2; }
    __device__ __forceinline__ unsigned row_off(const Unit&, int) const { return 0u; }
};
typedef DenseT<> Dense;
template <bool GATH, bool F8 = false, int SW_ = 0x7F7F7F7F, int SX_ = 0x7F7F7F7F> struct Grouped {
    static constexpr bool GATHER = GATH, FP8 = F8, HALFN = false; static constexpr int SW = SW_, SX = SX_;
    const bf16_t* A; const bf16_t* W; size_t estride; int ncol0; const LAS int* tile_e; const LAS int* tile_base; const LAS int* tile_nv; const int* ptok; int ntiles, nN, K, G, c;
    __device__ __forceinline__ bool next(int i, Unit& u) const { return static_next(ntiles, nN, G, c, i, u); }
    __device__ __forceinline__ const char* a_base(const Unit& u) const { return GATH ? (const char*)A : (const char*)A + (size_t)u.pm * 256 * K * 2; }
    __device__ __forceinline__ const char* b_base(const Unit& u) const { const int e = __builtin_amdgcn_readfirstlane(tile_e[u.pm]); return (const char*)W + ((size_t)e * estride + (size_t)(ncol0 + 256 * u.pn) * K) * 2; }
    __device__ __forceinline__ unsigned row_off(const Unit& u, int r) const { const int nv = tile_nv[u.pm]; const int tok = ptok[tile_base[u.pm] + (r < nv ? r : 0)]; return (unsigned)(r < nv ? tok : TT) * (unsigned)(K * 2); }
};

template <bool F8 = false, int SW_ = 0, int SX_ = 0> struct Merge3HT {
    static constexpr bool GATHER = false, FP8 = F8, HALFN = true; static constexpr int SW = SW_, SX = SX_;
    const bf16_t* A0; const bf16_t* A1; const bf16_t* A2; const bf16_t* B0; const bf16_t* B1; const bf16_t* B2; int nM, nN, K, G, c;
    __device__ __forceinline__ bool next(int i, Unit& u) const {
        const int j = i / 3; u.br = i - 3 * j;
        const int nwg = nM * nN; const long L = (long)j * G + c; if (L >= nwg) return false;
        int wgid = (int)L; { const int q = nwg / NXCD, r = nwg % NXCD, xcd = wgid % NXCD, off = wgid / NXCD; wgid = (xcd < r ? xcd * (q + 1) : r * (q + 1) + (xcd - r) * q) + off; }
        u.pm = wgid / nN; u.pn = wgid % nN; return true; }
    __device__ __forceinline__ const char* a_base(const Unit& u) const { const long d1 = (const char*)A1 - (const char*)A0, d2 = (const char*)A2 - (const char*)A0;
        return (const char*)A0 + (long)(u.br & 1) * d1 + (long)(u.br >> 1) * d2 + (size_t)u.pm * 256 * K * 2; }
    __device__ __forceinline__ const char* b_base(const Unit& u) const { const long d1 = (const char*)B1 - (const char*)B0, d2 = (const char*)B2 - (const char*)B0;
        return (const char*)B0 + (long)(u.br & 1) * d1 + (long)(u.br >> 1) * d2 + (size_t)u.pn * 128 * K * 2; }
    __device__ __forceinline__ unsigned row_off(const Unit&, int) const { return 0u; }
};

#ifndef PG8_SP2
#define PG8_SP2 1
#endif
template <bool F8> struct Frag { bf16x8 k0, k1;
    __device__ __forceinline__ void load(const LAS unsigned char* p) { k0 = *(const LAS bf16x8*)p; k1 = *(const LAS bf16x8*)(p + 1024); } };
template <> struct Frag<true> { i32x8 w;
    __device__ __forceinline__ void load(const LAS unsigned char* p) { w = *(const LAS i32x8*)p; } };
template <class Epi, class Prob>
__device__ __forceinline__ void gemm_phase(LAS unsigned char* lds, const Prob& P, const Epi& E) {
    constexpr bool SP2 = PG8_SP2 != 0, ALIGN_EPI = PG8_SP2 != 0, HN = Prob::HALFN;
    const int tid = threadIdx.x, wid = __builtin_amdgcn_readfirstlane(tid >> 6), lane = tid & 63, wr = wid >> 2, wc = wid & 3, fr = lane & 15, fq = lane >> 4;
    const int K = P.K, nt = K / BK;
    int Rst[2]; unsigned voffA[2], voffB[2];
#pragma unroll
    for (int i = 0; i < 2; ++i) { int R, C; stage_rc(tid * 16 + i * 8192, R, C); const int Rb = (R & ~31) + perm32(R & 31); Rst[i] = R;
        voffA[i] = (unsigned)(R * K + C) * 2u; voffB[i] = (unsigned)(Rb * K + C) * 2u; if (Prob::GATHER) voffA[i] = (unsigned)C * 2u; }
    const size_t kstep = (size_t)(BK * 2);
    const size_t hstep = (size_t)HALF * K * 2;
    const size_t hstepA = Prob::GATHER ? 0 : hstep;
    const unsigned ldsw = (unsigned)wid * 1024u;
    const int aoff = Prob::FP8 ? lds_byte(wr * 64 + fr, fq * 16) : lds_byte(wr * 64 + fr, fq * 8), boff = Prob::FP8 ? lds_byte(wc * 32 + fr, fq * 16) : lds_byte(wc * 32 + fr, fq * 8);
#define PG8_SA(b, h) (((b) * 2 + (h)) * HTB)
#define PG8_SB(b, h) ((4 + (b) * 2 + (h)) * HTB)
#define PG8_STAGE(bufoff, gbase, voff) do { _Pragma("unroll") for (int _i = 0; _i < 2; ++_i) \
        __builtin_amdgcn_global_load_lds((const unsigned*)((const char*)(gbase) + (voff)[_i]), (LAS unsigned*)(lds + (bufoff) + ldsw + _i * 8192), 16, 0, 0); } while (0)
#define PG8_STAGEA(bufoff, gbase, h, nx) do { _Pragma("unroll") for (int _i = 0; _i < 2; ++_i) { \
        const unsigned _ro = Prob::GATHER ? ((nx) ? groN[h][_i] : groC[h][_i]) : 0u; \
        __builtin_amdgcn_global_load_lds((const unsigned*)(((const char*)(gbase) + (size_t)(h) * hstepA) + (unsigned)(_ro + voffA[_i])), (LAS unsigned*)(lds + (bufoff) + ldsw + _i * 8192), 16, 0, 0); } } while (0)
#define PG8_LDA(dst, b, h) do { _Pragma("unroll") for (int m = 0; m < 4; ++m) dst[m].load(lds + PG8_SA(b, h) + aoff + m * 2048); } while (0)
#define PG8_LDB(dst, b, h) do { _Pragma("unroll") for (int n = 0; n < 2; ++n) dst[n].load(lds + PG8_SB(b, h) + boff + n * 2048); } while (0)
#define PG8_MMA(ai, bj, At, Bt) do { __builtin_amdgcn_s_setprio(1); _Pragma("unroll") for (int m = 0; m < 4; ++m) _Pragma("unroll") for (int n = 0; n < 2; ++n) { \
        if constexpr (Prob::FP8) {   \
              \
            asm volatile("v_mfma_scale_f32_16x16x128_f8f6f4 %0, %1, %2, %0, %3, %3 op_sel_hi:[0,0,0]" : "+v"(acc[ai][bj][m][n]) : "v"(Bt[n].w), "v"(At[m].w), "v"(mxscale)); \
        } else { acc[ai][bj][m][n] = __builtin_amdgcn_mfma_f32_16x16x32_bf16(Bt[n].k0, At[m].k0, acc[ai][bj][m][n], 0, 0, 0); \
                 acc[ai][bj][m][n] = __builtin_amdgcn_mfma_f32_16x16x32_bf16(Bt[n].k1, At[m].k1, acc[ai][bj][m][n], 0, 0, 0); } } \
        __builtin_amdgcn_s_setprio(0); } while (0)
#define PG8_WAIT_V(n) asm volatile("s_waitcnt vmcnt(" #n ")" ::: "memory")
#define PG8_STAGE_B1(bufoff, gbase, voff) do { if constexpr (!HN) PG8_STAGE(bufoff, gbase, voff); } while (0)
#define PG8_LDB1(dst, b, h) do { if constexpr (!HN) PG8_LDB(dst, b, h); } while (0)
#define PG8_MMA1(ai, bj, At, Bt) do { if constexpr (!HN) PG8_MMA(ai, bj, At, Bt); } while (0)
#define PG8_WAIT_LOOP do { if constexpr (HN) PG8_WAIT_V(6); else PG8_WAIT_V(8); } while (0)
#define PG8_WAIT_L(n) asm volatile("s_waitcnt lgkmcnt(" #n ")" ::: "memory")
#define PG8_BAR __builtin_amdgcn_s_barrier()
#define PG8_SCHED __builtin_amdgcn_sched_barrier(0)
    Unit cur, nxt; int ui = 0;
    if (!P.next(0, cur)) return;
    f32x4 acc[2][2][4][2];
#pragma unroll
    for (int a = 0; a < 2; ++a)
#pragma unroll
        for (int b = 0; b < 2; ++b)
#pragma unroll
            for (int m = 0; m < 4; ++m)
#pragma unroll
                for (int n = 0; n < 2; ++n) acc[a][b][m][n] = (f32x4){0.f, 0.f, 0.f, 0.f};
    Frag<Prob::FP8> At[4], B0[2], B1[2];
    const int mxscale = Prob::SW;
    unsigned groC[2][2] = {{0u, 0u}, {0u, 0u}}, groN[2][2] = {{0u, 0u}, {0u, 0u}};
    if (Prob::GATHER) {
#pragma unroll
        for (int h = 0; h < 2; ++h)
#pragma unroll
            for (int i = 0; i < 2; ++i) groC[h][i] = P.row_off(cur, h * HALF + Rst[i]);
    }
    const char* cA = P.a_base(cur); const char* cB = P.b_base(cur);
    if constexpr (SP2) {
        PG8_STAGE(PG8_SB(0, 0), cB, voffB); PG8_STAGE_B1(PG8_SB(0, 1), cB + hstep, voffB); PG8_STAGEA(PG8_SA(0, 0), cA, 0, false); PG8_STAGEA(PG8_SA(0, 1), cA, 1, false);
        if (wr == 1) PG8_BAR;
        PG8_WAIT_V(2); PG8_BAR;
        PG8_STAGE(PG8_SB(1, 0), cB + kstep, voffB); PG8_STAGEA(PG8_SA(1, 0), cA + kstep, 0, false); PG8_STAGE_B1(PG8_SB(1, 1), cB + hstep + kstep, voffB);
        if constexpr (HN) PG8_WAIT_V(4); else PG8_WAIT_V(6);
        PG8_BAR;
    } else {
        PG8_STAGE(PG8_SB(0, 0), cB, voffB); PG8_STAGEA(PG8_SA(0, 0), cA, 0, false); PG8_STAGE(PG8_SB(0, 1), cB + hstep, voffB); PG8_STAGEA(PG8_SA(0, 1), cA, 1, false);
        if (wr == 1) PG8_BAR;
        PG8_WAIT_V(4); PG8_BAR;
        PG8_STAGE(PG8_SB(1, 0), cB + kstep, voffB); PG8_STAGEA(PG8_SA(1, 0), cA + kstep, 0, false); PG8_STAGE(PG8_SB(1, 1), cB + hstep + kstep, voffB);
        PG8_WAIT_V(6); PG8_BAR;
    }
    typename Epi::State est;
    for (;;) {
        const bool has_next = P.next(ui + 1, nxt);
        if constexpr (HN) E.prefetch(est, cur, wr, wc, fr, fq);
        const char* nA = has_next ? P.a_base(nxt) : cA; const char* nB = has_next ? P.b_base(nxt) : cB;
        if (Prob::GATHER) {
            const int pmn = has_next ? nxt.pm : cur.pm; Unit un; un.pm = pmn; un.pn = 0;
#pragma unroll
            for (int h = 0; h < 2; ++h)
#pragma unroll
                for (int i = 0; i < 2; ++i) groN[h][i] = P.row_off(un, h * HALF + Rst[i]);
        }
        for (int t = 0; t < nt; t += 2) {
            const bool last = (t == nt - 2);
            const char* a1 = cA + (size_t)(t + 1) * kstep;
            const char* a2 = last ? nA : cA + (size_t)(t + 2) * kstep; const char* b2 = last ? nB : cB + (size_t)(t + 2) * kstep;
            const char* a3 = a2 + kstep; const char* b3 = b2 + kstep;
            if constexpr (SP2) {
            PG8_LDB(B0, 0, 0); PG8_LDB1(B1, 0, 1); PG8_SCHED; PG8_LDA(At, 0, 0); PG8_STAGEA(PG8_SA(1, 1), a1, 1, false);
            PG8_WAIT_LOOP; PG8_WAIT_L(0); PG8_BAR; PG8_MMA(0, 0, At, B0); PG8_MMA1(0, 1, At, B1); PG8_BAR; PG8_SCHED;
            PG8_LDA(At, 0, 1); PG8_STAGE(PG8_SB(0, 0), b2, voffB); PG8_STAGE_B1(PG8_SB(0, 1), b2 + hstep, voffB); PG8_STAGEA(PG8_SA(0, 0), a2, 0, last);
            PG8_WAIT_LOOP; PG8_WAIT_L(0); PG8_BAR; PG8_MMA(1, 0, At, B0); PG8_MMA1(1, 1, At, B1); PG8_BAR; PG8_SCHED;
            PG8_LDB(B0, 1, 0); PG8_LDB1(B1, 1, 1); PG8_SCHED; PG8_LDA(At, 1, 0); PG8_STAGEA(PG8_SA(0, 1), a2, 1, last);
            PG8_WAIT_LOOP; PG8_WAIT_L(0); PG8_BAR; PG8_MMA(0, 0, At, B0); PG8_MMA1(0, 1, At, B1); PG8_BAR; PG8_SCHED;
            PG8_LDA(At, 1, 1); PG8_STAGE(PG8_SB(1, 0), b3, voffB); PG8_STAGE_B1(PG8_SB(1, 1), b3 + hstep, voffB); PG8_STAGEA(PG8_SA(1, 0), a3, 0, last);
            PG8_WAIT_LOOP; PG8_WAIT_L(0); PG8_BAR; PG8_MMA(1, 0, At, B0); PG8_MMA1(1, 1, At, B1); PG8_BAR; PG8_SCHED;
            } else {
            PG8_LDB(B0, 0, 0); PG8_SCHED; PG8_LDA(At, 0, 0); PG8_STAGEA(PG8_SA(1, 1), a1, 1, false);
            PG8_WAIT_L(8); PG8_BAR; PG8_WAIT_L(0); PG8_MMA(0, 0, At, B0); PG8_BAR; PG8_SCHED;
            PG8_LDB(B1, 0, 1); PG8_STAGE(PG8_SB(0, 0), b2, voffB);
            PG8_BAR; PG8_WAIT_L(0); PG8_MMA(0, 1, At, B1); PG8_BAR;
            PG8_LDA(At, 0, 1); PG8_STAGEA(PG8_SA(0, 0), a2, 0, last);
            PG8_BAR; PG8_WAIT_L(0); PG8_MMA(1, 0, At, B0); PG8_BAR; PG8_SCHED;
            PG8_STAGE(PG8_SB(0, 1), b2 + hstep, voffB);
            PG8_WAIT_V(6); PG8_BAR; PG8_MMA(1, 1, At, B1); PG8_BAR;
            PG8_LDB(B0, 1, 0); PG8_SCHED; PG8_LDA(At, 1, 0); PG8_STAGEA(PG8_SA(0, 1), a2, 1, last);
            PG8_WAIT_L(8); PG8_BAR; PG8_WAIT_L(0); PG8_MMA(0, 0, At, B0); PG8_BAR; PG8_SCHED;
            PG8_LDB(B1, 1, 1); PG8_STAGE(PG8_SB(1, 0), b3, voffB);
            PG8_BAR; PG8_WAIT_L(0); PG8_MMA(0, 1, At, B1); PG8_BAR;
            PG8_LDA(At, 1, 1); PG8_STAGEA(PG8_SA(1, 0), a3, 0, last);
            PG8_BAR; PG8_WAIT_L(0); PG8_MMA(1, 0, At, B0); PG8_BAR; PG8_SCHED;
            PG8_STAGE(PG8_SB(1, 1), b3 + hstep, voffB);
            PG8_WAIT_V(6); PG8_BAR; PG8_MMA(1, 1, At, B1); PG8_BAR;
                    }
        }
        if constexpr (ALIGN_EPI) { if (wr == 0) PG8_BAR; }
        if constexpr (Prob::FP8) asm volatile("s_nop 15\n\ts_nop 7" ::: "memory");
        if constexpr (HN) E.run(acc, est, cur, wr, wc, fr, fq); else E(acc, cur, wr, wc, fr, fq);
        if (!has_next) break;
#pragma unroll
        for (int a = 0; a < 2; ++a)
#pragma unroll
            for (int b = 0; b < 2; ++b)
#pragma unroll
                for (int m = 0; m < 4; ++m)
#pragma unroll
                    for (int n = 0; n < 2; ++n) acc[a][b][m][n] = (f32x4){0.f, 0.f, 0.f, 0.f};
        cur = nxt; cA = nA; cB = nB; ++ui;
        if (Prob::GATHER) {
#pragma unroll
            for (int h = 0; h < 2; ++h)
#pragma unroll
                for (int i = 0; i < 2; ++i) groC[h][i] = groN[h][i];
        }
        if constexpr (ALIGN_EPI) { if (wr == 1) PG8_BAR; }
    }
    PG8_WAIT_V(0);
    if constexpr (!ALIGN_EPI) { if (wr == 0) PG8_BAR; }
    PG8_BAR;
#undef PG8_SA
#undef PG8_SB
#undef PG8_STAGE
#undef PG8_STAGEA
#undef PG8_LDA
#undef PG8_LDB
#undef PG8_MMA
#undef PG8_WAIT_V
#undef PG8_STAGE_B1
#undef PG8_LDB1
#undef PG8_MMA1
#undef PG8_WAIT_LOOP
#undef PG8_WAIT_L
#undef PG8_BAR
#undef PG8_SCHED
}
}

#define EPI_ARGS const f32x4 (&acc)[2][2][4][2], const pg8::Unit& u, int wr, int wc, int fr, int fq
__device__ __forceinline__ u32x4 pack8(const f32x4& a, const f32x4& b) { u32x4 w; w.x = cvtpk(a[0], a[1]); w.y = cvtpk(a[2], a[3]); w.z = cvtpk(b[0], b[1]); w.w = cvtpk(b[2], b[3]); return w; }

struct EpiStore { struct State {};
    bf16_t* O; int ldo, lgin, gout, mrows;
    __device__ __forceinline__ void operator()(EPI_ARGS) const {
        const int row0 = u.pm * 256 + wr * 64 + fr;
#pragma unroll
        for (int bj = 0; bj < 2; ++bj) {
            const int c8 = u.pn * 256 + bj * 128 + wc * 32 + 8 * fq;
            const int dc = ((c8 >> lgin) * gout) + (c8 & ((1 << lgin) - 1));
#pragma unroll
            for (int ai = 0; ai < 2; ++ai)
#pragma unroll
                for (int m = 0; m < 4; ++m) { const int row = row0 + ai * 128 + m * 16;
                    *(u32x4*)(O + (size_t)row * ldo + dc) = pack8(acc[ai][bj][m][0], acc[ai][bj][m][1]); }
        }
    }
};
template <int W> __device__ __forceinline__ void rstd_rows(const bf16_t* src, int row0, int n, LAS float* tab, int lane) {
    constexpr int NV = W / 128;
    const int g = lane >> 4, sl = lane & 15;
    for (int i0 = 0; i0 < n; i0 += 16) {
        u32x4 w[4][NV];
#pragma unroll
        for (int p = 0; p < 4; ++p) { const bf16_t* q = src + (size_t)(row0 + i0 + 4 * p + g) * W + sl * (W / 16);
#pragma unroll
            for (int v = 0; v < NV; ++v) w[p][v] = *(const u32x4*)(q + 8 * v); }
#pragma unroll
        for (int p = 0; p < 4; ++p) { float ss = 0.f;
#pragma unroll
            for (int v = 0; v < NV; ++v)
#pragma unroll
                for (int e = 0; e < 4; ++e) { const float a = bflo(w[p][v][e]), b = bfhi(w[p][v][e]); ss += a * a + b * b; }
            ss += __shfl_xor(ss, 8); ss += __shfl_xor(ss, 4); ss += __shfl_xor(ss, 2); ss += __shfl_xor(ss, 1);
            if (sl == 0) tab[i0 + 4 * p + g] = rsqrtf(ss * (1.0f / (float)W) + NORM_EPS); }
    }
    asm volatile("s_waitcnt lgkmcnt(0)" ::: "memory");
}
template <int W> struct EpiStoreRS { struct State {};
    bf16_t* O; int ldo, lgin, gout; const bf16_t* src; LAS float* tab;
    __device__ __forceinline__ void operator()(EPI_ARGS) const {
        const int lane = fq * 16 + fr; LAS float* t = tab + wr * 128;
        { const int idx0 = wc * 32, ai0 = idx0 >> 6, loc0 = idx0 & 63; rstd_rows<W>(src, u.pm * 256 + ai0 * 128 + wr * 64 + loc0, 32, t + idx0, lane); }
        __syncthreads();
        const int row0 = u.pm * 256 + wr * 64 + fr;
#pragma unroll
        for (int bj = 0; bj < 2; ++bj) {
            const int c8 = u.pn * 256 + bj * 128 + wc * 32 + 8 * fq;
            const int dc = ((c8 >> lgin) * gout) + (c8 & ((1 << lgin) - 1));
#pragma unroll
            for (int ai = 0; ai < 2; ++ai)
#pragma unroll
                for (int m = 0; m < 4; ++m) { const int row = row0 + ai * 128 + m * 16; const float sc = t[ai * 64 + m * 16 + fr];
                    *(u32x4*)(O + (size_t)row * ldo + dc) = pack8(acc[ai][bj][m][0] * sc, acc[ai][bj][m][1] * sc); }
        }
    }
};
struct EpiStoreCS { struct State {};
    bf16_t* O; int ldo; const bf16_t* src; LAS float* tab;
    __device__ __forceinline__ void operator()(EPI_ARGS) const {
        const int wid = wr * 4 + wc, lane = fq * 16 + fr; LAS float* t = tab + 256 + wid * 64;
        rstd_rows<256>(src, u.pn * 256 + wc * 32, 32, t, lane); rstd_rows<256>(src, u.pn * 256 + 128 + wc * 32, 32, t + 32, lane);
        const int row0 = u.pm * 256 + wr * 64 + fr;
#pragma unroll
        for (int bj = 0; bj < 2; ++bj) {
            const int c8 = u.pn * 256 + bj * 128 + wc * 32 + 8 * fq;
            const f32x4 s0 = *(const LAS f32x4*)(t + bj * 32 + 8 * fq), s1 = *(const LAS f32x4*)(t + bj * 32 + 8 * fq + 4);
#pragma unroll
            for (int ai = 0; ai < 2; ++ai)
#pragma unroll
                for (int m = 0; m < 4; ++m) { const int row = row0 + ai * 128 + m * 16;
                    *(u32x4*)(O + (size_t)row * ldo + c8) = pack8(acc[ai][bj][m][0] * s0, acc[ai][bj][m][1] * s1); }
        }
    }
};
struct EpiResid { struct State {};
    bf16_t* X; const float* xlat; const float* xctx; const float* mod2;
    __device__ __forceinline__ void operator()(EPI_ARGS) const {
        const int t0 = u.pm * 256; const float* gt = mod2 + (size_t)tok_modrow(t0) * 6 * 1024;
        const int row0 = t0 + wr * 64 + fr;
#pragma unroll
        for (int bj = 0; bj < 2; ++bj) {
            const int c8 = u.pn * 256 + bj * 128 + wc * 32 + 8 * fq;
            const f32x4 g0 = *(const f32x4*)(gt + c8), g1 = *(const f32x4*)(gt + c8 + 4);
#pragma unroll
            for (int ai = 0; ai < 2; ++ai)
#pragma unroll
                for (int m = 0; m < 4; ++m) { const int row = row0 + ai * 128 + m * 16; bf16_t* xo = X + (size_t)row * 1024 + c8;
                    f32x4 x0, x1;
                    if (xlat != nullptr) { const float* xr = (t0 < TL ? xlat + (size_t)row * 1024 : xctx + (size_t)(row - TL) * 1024) + c8; x0 = __builtin_nontemporal_load((const f32x4*)xr); x1 = __builtin_nontemporal_load((const f32x4*)(xr + 4)); }
                    else { const u32x4 w = *(const u32x4*)xo; x0 = (f32x4){bflo(w.x), bfhi(w.x), bflo(w.y), bfhi(w.y)}; x1 = (f32x4){bflo(w.z), bfhi(w.z), bflo(w.w), bfhi(w.w)}; }
                    *(u32x4*)xo = pack8(x0 + g0 * acc[ai][bj][m][0], x1 + g1 * acc[ai][bj][m][1]); }
        }
    }
};
struct EpiSeg { struct State {};
    unsigned char* act;
    __device__ __forceinline__ void operator()(EPI_ARGS) const {
        const int row0 = u.pm * 256 + wr * 64 + fr;
#pragma unroll
        for (int bj = 0; bj < 2; ++bj) {
            const int c32 = u.pn * 256 + bj * 128 + wc * 32;
            if (c32 >= OFF_VS) continue;
            size_t base; int ld, c0;
            if (c32 < OFF_CKV)      { base = A_CQ;  ld = 384; c0 = OFF_CQ; }
            else if (c32 < OFF_KR)  { base = A_CKV; ld = 256; c0 = OFF_CKV; }
            else if (c32 < OFF_U)   { base = A_KR;  ld = 32;  c0 = OFF_KR; }
            else if (c32 < OFF_QS)  { base = A_U;   ld = 512; c0 = OFF_U; }
            else if (c32 < OFF_KS)  { base = A_QS;  ld = 512; c0 = OFF_QS; }
            else                    { base = A_KSR; ld = 128; c0 = OFF_KS; }
            bf16_t* O = (bf16_t*)(act + base);
            const int dc = c32 - c0 + 8 * fq;
#pragma unroll
            for (int ai = 0; ai < 2; ++ai)
#pragma unroll
                for (int m = 0; m < 4; ++m) { const int row = row0 + ai * 128 + m * 16;
                    *(u32x4*)(O + (size_t)row * ld + dc) = pack8(acc[ai][bj][m][0], acc[ai][bj][m][1]); }
        }
    }
};
template <int PASS> struct EpiMerge { struct State {};
    bf16_t* out; const bf16_t* gates; int mrows;
    __device__ __forceinline__ void operator()(EPI_ARGS) const {
        const int row0 = u.pm * 256 + wr * 64 + fr;
#pragma unroll
        for (int bj = 0; bj < 2; ++bj) {
            const int c8 = u.pn * 256 + bj * 128 + wc * 32 + 8 * fq;
#pragma unroll
            for (int ai = 0; ai < 2; ++ai)
#pragma unroll
                for (int m = 0; m < 4; ++m) { const int row = row0 + ai * 128 + m * 16;
                    const u32x4 g = *(const u32x4*)(gates + (size_t)row * 3072 + PASS * 1024 + c8);
                    f32x4 v0 = acc[ai][bj][m][0], v1 = acc[ai][bj][m][1];
                    v0[0] *= bflo(g.x); v0[1] *= bfhi(g.x); v0[2] *= bflo(g.y); v0[3] *= bfhi(g.y);
                    v1[0] *= bflo(g.z); v1[1] *= bfhi(g.z); v1[2] *= bflo(g.w); v1[3] *= bfhi(g.w);
                    bf16_t* op = out + (size_t)row * 1024 + c8;
                    if (PASS > 0) { const u32x4 p = *(const u32x4*)op;
                        v0[0] += bflo(p.x); v0[1] += bfhi(p.x); v0[2] += bflo(p.y); v0[3] += bfhi(p.y);
                        v1[0] += bflo(p.z); v1[1] += bfhi(p.z); v1[2] += bflo(p.w); v1[3] += bfhi(p.w); }
                    *(u32x4*)op = pack8(v0, v1); }
        }
    }
};
__device__ __forceinline__ void swap16_pair(u32x2& x, u32x2& y) {
    auto r0 = __builtin_amdgcn_permlane16_swap(x.x, y.x, false, false); x.x = r0[0]; y.x = r0[1];
    auto r1 = __builtin_amdgcn_permlane16_swap(x.y, y.y, false, false); x.y = r1[0]; y.y = r1[1];
}
struct EpiGate8 { struct State {};
    unsigned char* gates;
    __device__ __forceinline__ void operator()(EPI_ARGS) const {
        const int row0 = u.pm * 256 + wr * 64 + fr + (fq & 1) * 16;
#pragma unroll
        for (int bj = 0; bj < 2; ++bj) {
            const int cb = u.pn * 256 + bj * 128 + wc * 32 + 16 * (fq >> 1);
#pragma unroll
            for (int ai = 0; ai < 2; ++ai)
#pragma unroll
                for (int mp = 0; mp < 4; mp += 2) { u32x2 p[2];
                    float g[16];
#pragma unroll
                    for (int h = 0; h < 2; ++h)
#pragma unroll
                        for (int e = 0; e < 4; ++e) { g[8 * h + e] = __builtin_amdgcn_exp2f(acc[ai][bj][mp + h][0][e]); g[8 * h + 4 + e] = __builtin_amdgcn_exp2f(acc[ai][bj][mp + h][1][e]); }
#pragma unroll
                    for (int e = 0; e < 16; ++e) g[e] = fmaf(g[e], 1.0f / 255.0f, 1.0f / 255.0f);
#pragma unroll
                    for (int e = 0; e < 16; ++e) g[e] = __builtin_amdgcn_rcpf(g[e]);
#pragma unroll
                    for (int h = 0; h < 2; ++h) { unsigned w0 = 0u, w1 = 0u;
#pragma unroll
                        for (int e = 0; e < 4; ++e) { w0 = __builtin_amdgcn_cvt_pk_u8_f32(g[8 * h + e], e, w0); w1 = __builtin_amdgcn_cvt_pk_u8_f32(g[8 * h + 4 + e], e, w1); }
                        p[h] = (u32x2){w0, w1}; }
                    swap16_pair(p[0], p[1]);
                    *(u32x4*)(gates + (size_t)(row0 + ai * 128 + mp * 16) * 3072 + cb) = (u32x4){p[0].x, p[0].y, p[1].x, p[1].y}; }
        }
    }
};
struct EpiMerge3H {
    struct State { u32x4 mg[2][4]; u32x4 gp[2][2]; };
    bf16_t* out; const unsigned char* gates;
    __device__ __forceinline__ void prefetch(State& st, const pg8::Unit& u, int wr, int wc, int fr, int fq) const {
        const int row0 = u.pm * 256 + wr * 64 + fr + (fq & 1) * 16, cb = u.pn * 128 + wc * 32 + 16 * (fq >> 1);
#pragma unroll
        for (int ai = 0; ai < 2; ++ai)
#pragma unroll
            for (int mp = 0; mp < 2; ++mp) st.gp[ai][mp] = *(const u32x4*)(gates + (size_t)(row0 + ai * 128 + mp * 32) * 3072 + u.br * 1024 + cb);
    }
    __device__ __forceinline__ void run(const f32x4 (&acc)[2][2][4][2], State& st, const pg8::Unit& u, int wr, int wc, int fr, int fq) const {
        const int row0 = u.pm * 256 + wr * 64 + fr, c8 = u.pn * 128 + wc * 32 + 8 * fq;
#pragma unroll
        for (int ai = 0; ai < 2; ++ai)
#pragma unroll
            for (int m = 0; m < 4; ++m) { u32x2 gx = (u32x2){st.gp[ai][m >> 1].x, st.gp[ai][m >> 1].y}, gy = (u32x2){st.gp[ai][m >> 1].z, st.gp[ai][m >> 1].w};
                swap16_pair(gx, gy); const u32x2 g = (m & 1) ? gy : gx; constexpr float q = 1.0f / 255.0f;
                f32x4 v0 = acc[ai][0][m][0] * q, v1 = acc[ai][0][m][1] * q;
                v0[0] *= (float)((g.x >> 0) & 0xffu); v0[1] *= (float)((g.x >> 8) & 0xffu); v0[2] *= (float)((g.x >> 16) & 0xffu); v0[3] *= (float)((g.x >> 24) & 0xffu);
                v1[0] *= (float)((g.y >> 0) & 0xffu); v1[1] *= (float)((g.y >> 8) & 0xffu); v1[2] *= (float)((g.y >> 16) & 0xffu); v1[3] *= (float)((g.y >> 24) & 0xffu);
                if (u.br != 0) { const u32x4 p = st.mg[ai][m];
                    v0[0] += bflo(p.x); v0[1] += bfhi(p.x); v0[2] += bflo(p.y); v0[3] += bfhi(p.y);
                    v1[0] += bflo(p.z); v1[1] += bfhi(p.z); v1[2] += bflo(p.w); v1[3] += bfhi(p.w); }
                const u32x4 w = pack8(v0, v1);
                if (u.br == 2) *(u32x4*)(out + (size_t)(row0 + ai * 128 + m * 16) * 1024 + c8) = w; else st.mg[ai][m] = w; }
    }
};
struct EpiG6 { struct State {};
    bf16_t* hs; float* logits; float* logits2; int mrows;
    __device__ __forceinline__ void operator()(EPI_ARGS) const {
        const int row0 = u.pm * 256 + wr * 64 + fr;
        if (u.pn < 2) {
            const int dc = u.pn * 128 + wc * 32 + 8 * fq;
#pragma unroll
            for (int ai = 0; ai < 2; ++ai)
#pragma unroll
                for (int mp = 0; mp < 4; mp += 2) { float sg[16];
#pragma unroll
                    for (int h = 0; h < 2; ++h)
#pragma unroll
                        for (int e = 0; e < 4; ++e) { sg[8 * h + e] = __builtin_amdgcn_exp2f(acc[ai][0][mp + h][0][e] * -LOG2E); sg[8 * h + 4 + e] = __builtin_amdgcn_exp2f(acc[ai][0][mp + h][1][e] * -LOG2E); }
#pragma unroll
                    for (int e = 0; e < 16; ++e) sg[e] = 1.0f + sg[e];
#pragma unroll
                    for (int e = 0; e < 16; ++e) sg[e] = __builtin_amdgcn_rcpf(sg[e]);
#pragma unroll
                    for (int h = 0; h < 2; ++h) { const int row = row0 + ai * 128 + (mp + h) * 16; f32x4 v0, v1;
#pragma unroll
                        for (int e = 0; e < 4; ++e) { v0[e] = acc[ai][0][mp + h][0][e] * sg[8 * h + e] * acc[ai][1][mp + h][0][e]; v1[e] = acc[ai][0][mp + h][1][e] * sg[8 * h + 4 + e] * acc[ai][1][mp + h][1][e]; }
                        *(u32x4*)(hs + (size_t)row * 256 + dc) = pack8(v0, v1); } }
        } else {
            const int dc = (wc & 1) * 32 + 8 * fq; float* lg = (wc < 2) ? logits : logits2;
#pragma unroll
            for (int ai = 0; ai < 2; ++ai)
#pragma unroll
                for (int m = 0; m < 4; ++m) { const int row = row0 + ai * 128 + m * 16;
                    float* lp = lg + (size_t)row * 64 + dc;
                    *(f32x4*)lp = acc[ai][0][m][0]; *(f32x4*)(lp + 4) = acc[ai][0][m][1]; }
        }
    }
};
typedef float f32x2v __attribute__((ext_vector_type(2)));
constexpr float Y8_SCALE = 16.0f;
constexpr float F8_SCALE = 8.0f, W8_SCALE = 128.0f, H8_SCALE = 32.0f;
struct EpiG7 { struct State {};
    unsigned char* hmid; const float* pwt; const LAS int* tile_base; const LAS int* tile_nv;
    __device__ __forceinline__ void operator()(EPI_ARGS) const {
        const int rl0 = wr * 64 + fr; const int tbase = tile_base[u.pm], nv = tile_nv[u.pm];
        const int cb = u.pn * 128 + wc * 32 + 16 * (fq >> 1);
#pragma unroll
        for (int ai = 0; ai < 2; ++ai)
#pragma unroll
            for (int mp = 0; mp < 4; mp += 2) { u32x2 p[2];
                float wr2[2];
#pragma unroll
                for (int h = 0; h < 2; ++h) { const int rl = rl0 + ai * 128 + (mp + h) * 16; wr2[h] = (rl < nv ? pwt[tbase + rl] : 0.f) * H8_SCALE; }
                float sg[16];
#pragma unroll
                for (int h = 0; h < 2; ++h)
#pragma unroll
                    for (int e = 0; e < 4; ++e) { sg[8 * h + e] = __builtin_amdgcn_exp2f(acc[ai][0][mp + h][0][e] * -LOG2E); sg[8 * h + 4 + e] = __builtin_amdgcn_exp2f(acc[ai][0][mp + h][1][e] * -LOG2E); }
#pragma unroll
                for (int e = 0; e < 16; ++e) sg[e] = 1.0f + sg[e];
#pragma unroll
                for (int e = 0; e < 16; ++e) sg[e] = __builtin_amdgcn_rcpf(sg[e]);
#pragma unroll
                for (int h = 0; h < 2; ++h) { f32x4 v0, v1;
#pragma unroll
                    for (int e = 0; e < 4; ++e) { v0[e] = acc[ai][0][mp + h][0][e] * sg[8 * h + e] * acc[ai][1][mp + h][0][e] * wr2[h]; v1[e] = acc[ai][0][mp + h][1][e] * sg[8 * h + 4 + e] * acc[ai][1][mp + h][1][e] * wr2[h]; }
                    p[h] = (u32x2){fp8x4s(v0[0], v0[1], v0[2], v0[3]), fp8x4s(v1[0], v1[1], v1[2], v1[3])}; }
                swap16_pair(p[0], p[1]);
                const int row = u.pm * 256 + rl0 + ai * 128 + (mp + (fq & 1)) * 16;
                *(u32x4*)(hmid + (size_t)row * 256 + cb) = (u32x4){p[0].x, p[0].y, p[1].x, p[1].y}; }
    }
};

struct EpiY8 { struct State {};
    unsigned char* Y; const LAS int* tile_nv;
    __device__ __forceinline__ void operator()(EPI_ARGS) const {
        const int rl0 = wr * 64 + fr + (fq & 1) * 16, row0 = u.pm * 256 + rl0; const int nv = tile_nv ? tile_nv[u.pm] : 256;
#pragma unroll
        for (int bj = 0; bj < 2; ++bj) {
            const int cb = u.pn * 256 + bj * 128 + wc * 32 + 16 * (fq >> 1);
#pragma unroll
            for (int ai = 0; ai < 2; ++ai)
#pragma unroll
                for (int mp = 0; mp < 4; mp += 2) { u32x2 p[2];
#pragma unroll
                    for (int h = 0; h < 2; ++h) { const f32x4 v0 = acc[ai][bj][mp + h][0] * Y8_SCALE, v1 = acc[ai][bj][mp + h][1] * Y8_SCALE;
                        p[h] = (u32x2){fp8x4(v0[0], v0[1], v0[2], v0[3]), fp8x4(v1[0], v1[1], v1[2], v1[3])}; }
                    swap16_pair(p[0], p[1]);
                    if (rl0 + ai * 128 + mp * 16 < nv) *(u32x4*)(Y + (size_t)(row0 + ai * 128 + mp * 16) * 1024 + cb) = (u32x4){p[0].x, p[0].y, p[1].x, p[1].y}; }
        }
    }
};

struct AttnSeg { const bf16_t* k; const bf16_t* vt; int ntiles; int kpos0; };
__device__ __forceinline__ float att_max3(float a, float b, float c) { return __builtin_fmaxf(__builtin_fmaxf(a, b), c); }
template <int DQK, bool BAND, bool SINK, bool QROPE, bool QSWA = false>
__device__ __forceinline__ void attn_unit(LAS unsigned char* lds, const bf16_t* qrow0, int qpitch, unsigned char* orow0, int opitch,
                                          AttnSeg s0, AttnSeg s1, int kpitch, int vpitch, int qpos0, float sink2, const float* tabm) {
    constexpr int NS = DQK / 16, KP = DQK * 2 + 16, VP = 136, KBUF = 64 * KP, VBUF = 64 * VP, CPR = DQK / 8, NCH = 64 * CPR;
    const int tid = threadIdx.x, lane = tid & 63, r = lane & 31, hh = lane >> 5;
    LAS unsigned char* Kb = lds; LAS unsigned char* Vb = lds + 2 * KBUF;
    bf16x8 qf[NS];
#pragma unroll
    for (int s = 0; s < NS; ++s) qf[s] = *(const bf16x8*)(qrow0 + (size_t)r * qpitch + 16 * s + 8 * hh);
    if (QROPE) {
        const int spos = (qpos0 + r) & 4095;
#pragma unroll
        for (int f = 4; f < 6; ++f) { const int pos = (f == 4) ? (spos >> 6) : (spos & 63); const float* cs = tabm + pos * 8; const float* sn = tabm + 512 + pos * 8;
            const u32x4 mine = __builtin_bit_cast(u32x4, qf[f]); u32x4 oth;
#pragma unroll
            for (int q = 0; q < 4; ++q) { auto rr = __builtin_amdgcn_permlane32_swap(mine[q], mine[q], false, false); oth[q] = hh ? rr[0] : rr[1]; }
            float a[8], b[8]; unpack8(mine, a); unpack8(oth, b);
#pragma unroll
            for (int e = 0; e < 8; ++e) a[e] = hh ? (a[e] * cs[e] + b[e] * sn[e]) : (a[e] * cs[e] - b[e] * sn[e]);
            qf[f] = __builtin_bit_cast(bf16x8, packf8(a)); }
    }
    if (QSWA) {
        const int spos = (qpos0 + r) & 4095;
#pragma unroll
        for (int f = 0; f < 4; f += 2) { float a[8], b[8]; unpack8(__builtin_bit_cast(u32x4, qf[f]), a); unpack8(__builtin_bit_cast(u32x4, qf[f + 1]), b);
            if (tabm != nullptr) { const int pos = (f == 0) ? (spos >> 6) : (spos & 63); const float* cs = tabm + pos * 16 + 8 * hh; const float* sn = tabm + 1024 + pos * 16 + 8 * hh;
#pragma unroll
                for (int e = 0; e < 8; ++e) { const float x = a[e] * cs[e] - b[e] * sn[e], y = b[e] * cs[e] + a[e] * sn[e]; a[e] = x; b[e] = y; } }
#pragma unroll
            for (int e = 0; e < 8; ++e) { a[e] *= SWA_QSCALE; b[e] *= SWA_QSCALE; }
            qf[f] = __builtin_bit_cast(bf16x8, packf8(a)); qf[f + 1] = __builtin_bit_cast(bf16x8, packf8(b)); }
    }
    const int ntot = s0.ntiles + s1.ntiles;
    const int kc0 = tid, kc1 = tid + 512;
    const int kr0 = kc0 / CPR, kq0 = kc0 % CPR, kr1 = kc1 / CPR, kq1 = kc1 % CPR;
    const bool k1ok = kc1 < NCH;
    const int vd = tid >> 3, vq = tid & 7;
    u32x4 kA0, kA1 = {0u, 0u, 0u, 0u}, vA, kB0, kB1 = {0u, 0u, 0u, 0u}, vB;
#define ATT_LOAD(it) do { const bool _s1 = (it) >= s0.ntiles; const int _j = _s1 ? (it) - s0.ntiles : (it); const bf16_t* _k = _s1 ? s1.k : s0.k; const bf16_t* _v = _s1 ? s1.vt : s0.vt; \
        kreg0 = *(const u32x4*)(_k + (size_t)(_j * 64 + kr0) * kpitch + kq0 * 8); \
        if (k1ok) kreg1 = *(const u32x4*)(_k + (size_t)(_j * 64 + kr1) * kpitch + kq1 * 8); \
        vreg = *(const u32x4*)(_v + (size_t)vd * vpitch + _j * 64 + vq * 8); } while (0)
#define ATT_STORE(buf) do { *(LAS u32x4*)(Kb + (buf) * KBUF + kr0 * KP + kq0 * 16) = kreg0; \
        if (k1ok) *(LAS u32x4*)(Kb + (buf) * KBUF + kr1 * KP + kq1 * 16) = kreg1; \
        LAS unsigned char* _vp = Vb + (buf) * VBUF + vd * VP + vq * 16; *(LAS u32x2*)_vp = (u32x2){vreg.x, vreg.y}; *(LAS u32x2*)(_vp + 8) = (u32x2){vreg.z, vreg.w}; } while (0)
    f32x16 ot0 = {}, ot1 = {};
#define ATT_KLOAD(kreg0, kreg1, it) do { const bool _s1 = (it) >= s0.ntiles; const int _j = _s1 ? (it) - s0.ntiles : (it); const bf16_t* _k = _s1 ? s1.k : s0.k; \
        kreg0 = *(const u32x4*)(_k + (size_t)(_j * 64 + kr0) * kpitch + kq0 * 8); \
        if (k1ok) kreg1 = *(const u32x4*)(_k + (size_t)(_j * 64 + kr1) * kpitch + kq1 * 8); } while (0)
#define ATT_VLOAD(vreg, it) do { const bool _s1 = (it) >= s0.ntiles; const int _j = _s1 ? (it) - s0.ntiles : (it); const bf16_t* _v = _s1 ? s1.vt : s0.vt; \
        vreg = *(const u32x4*)(_v + (size_t)vd * vpitch + _j * 64 + vq * 8); } while (0)
#define ATT_KSTORE(kreg0, kreg1, buf) do { *(LAS u32x4*)(Kb + (buf) * KBUF + kr0 * KP + kq0 * 16) = kreg0; \
        if (k1ok) *(LAS u32x4*)(Kb + (buf) * KBUF + kr1 * KP + kq1 * 16) = kreg1; } while (0)
#define ATT_VSTORE(vreg, buf) do { LAS unsigned char* _vp = Vb + (buf) * VBUF + vd * VP + vq * 16; *(LAS u32x2*)_vp = (u32x2){vreg.x, vreg.y}; *(LAS u32x2*)(_vp + 8) = (u32x2){vreg.z, vreg.w}; } while (0)
#define ATT_QK(dst0, dst1, buf, cinit) do { const LAS unsigned char* _kp = Kb + (buf) * KBUF + r * KP + hh * 16; \
        _Pragma("unroll") for (int s = 0; s < NS; ++s) { \
            const bf16x8 _k0 = *(const LAS bf16x8*)(_kp + s * 32), _k1 = *(const LAS bf16x8*)(_kp + 32 * KP + s * 32); \
            dst0 = __builtin_amdgcn_mfma_f32_32x32x16_bf16(_k0, qf[s], s == 0 ? cinit : dst0, 0, 0, 0); \
            dst1 = __builtin_amdgcn_mfma_f32_32x32x16_bf16(_k1, qf[s], s == 0 ? cinit : dst1, 0, 0, 0); } } while (0)
#define ATT_ROWMAX(C0, C1, mx) do { float _b; mx = att_max3(C0[0], C0[1], C1[0]); _b = att_max3(C0[2], C0[3], C1[1]); mx = att_max3(mx, C1[2], C1[3]); \
        _Pragma("unroll") for (int i = 4; i < 16; i += 4) { mx = att_max3(mx, C0[i], C0[i + 1]); _b = att_max3(_b, C0[i + 2], C0[i + 3]); mx = att_max3(mx, C1[i], C1[i + 1]); _b = att_max3(_b, C1[i + 2], C1[i + 3]); } \
        mx = fmaxf(mx, _b);     \
        { auto rr = __builtin_amdgcn_permlane32_swap(__float_as_uint(mx), __float_as_uint(mx), false, false); mx = fmaxf(__uint_as_float(rr[0]), __uint_as_float(rr[1])); } } while (0)
    ATT_KLOAD(kA0, kA1, 0); ATT_VLOAD(vA, 0); ATT_KLOAD(kB0, kB1, 1); ATT_KSTORE(kA0, kA1, 0); ATT_VSTORE(vA, 0); ATT_KSTORE(kB0, kB1, 1);
    ATT_KLOAD(kA0, kA1, 2); ATT_VLOAD(vA, 1);
    ATT_KLOAD(kB0, kB1, 3); ATT_VLOAD(vB, 2);
    __syncthreads();
    f32x16 sa0, sa1, sb0, sb1, ol = {}; const f32x16 negm = {};
    const bf16x8 ones = {0x3F80, 0x3F80, 0x3F80, 0x3F80, 0x3F80, 0x3F80, 0x3F80, 0x3F80};
    ATT_QK(sa0, sa1, 0, negm);
    float m_run, d_cur = 0.f;
    { ATT_ROWMAX(sa0, sa1, m_run);
#pragma unroll
      for (int i = 0; i < 16; ++i) { sa0[i] -= m_run; sa1[i] -= m_run; } }
    __syncthreads();
#define SBAR() __builtin_amdgcn_sched_barrier(0)
#define ATT_RM(C0, C1, i) do { if ((i) == 0) mx = att_max3(C0[0], C0[1], C1[0]); else if ((i) == 1) mb = att_max3(C0[2], C0[3], C1[1]); else if ((i) == 2) mx = att_max3(mx, C1[2], C1[3]); \
        else if ((i) < 15) { constexpr int _dummy = 0; const int _q = ((i) - 3) >> 2, _w = ((i) - 3) & 3, _b4 = 4 + 4 * _q; (void)_dummy; \
            if (_w == 0) mx = att_max3(mx, C0[_b4], C0[_b4 + 1]); else if (_w == 1) mb = att_max3(mb, C0[_b4 + 2], C0[_b4 + 3]); \
            else if (_w == 2) mx = att_max3(mx, C1[_b4], C1[_b4 + 1]); else mb = att_max3(mb, C1[_b4 + 2], C1[_b4 + 3]); } } while (0)
#define ATT_EXP4(C0, C1, g, h) do { _Pragma("unroll") for (int e = 0; e < 4; ++e) { if (((g) >> 1) == 0) C0[8 * ((g) & 1) + 4 * (h) + e] = __builtin_amdgcn_exp2f(C0[8 * ((g) & 1) + 4 * (h) + e]); \
        else C1[8 * ((g) & 1) + 4 * (h) + e] = __builtin_amdgcn_exp2f(C1[8 * ((g) & 1) + 4 * (h) + e]); } } while (0)
#define ATT_CVT4(C0, C1, g) do { const int _o = 8 * ((g) & 1); if (((g) >> 1) == 0) { pw[g].x = cvtpk(C0[_o + 0], C0[_o + 1]); pw[g].y = cvtpk(C0[_o + 2], C0[_o + 3]); pw[g].z = cvtpk(C0[_o + 4], C0[_o + 5]); pw[g].w = cvtpk(C0[_o + 6], C0[_o + 7]); } \
        else { pw[g].x = cvtpk(C1[_o + 0], C1[_o + 1]); pw[g].y = cvtpk(C1[_o + 2], C1[_o + 3]); pw[g].z = cvtpk(C1[_o + 4], C1[_o + 5]); pw[g].w = cvtpk(C1[_o + 6], C1[_o + 7]); } } while (0)
#define ATT_VFRAG(dst0_, dst1_, vp_, g) do { const int _ko = 32 * (g); \
        const s16x4 _a0l = *(const LAS s16x4*)((vp_) + _ko), _a0h = *(const LAS s16x4*)((vp_) + _ko + 16); \
        const s16x4 _a1l = *(const LAS s16x4*)((vp_) + 32 * VP + _ko), _a1h = *(const LAS s16x4*)((vp_) + 32 * VP + _ko + 16); \
        dst0_ = (bf16x8){_a0l[0], _a0l[1], _a0l[2], _a0l[3], _a0h[0], _a0h[1], _a0h[2], _a0h[3]}; \
        dst1_ = (bf16x8){_a1l[0], _a1l[1], _a1l[2], _a1l[3], _a1h[0], _a1h[1], _a1h[2], _a1h[3]}; } while (0)
#define ATT_STEP(C0, C1, N0, N1, it, buf, kr0_, kr1_, vr_) do { \
        const bool hasn = (it) + 1 < ntot; \
        if (BAND) { if ((it) >= s0.ntiles) { const int _kb = s1.kpos0 + ((it) - s0.ntiles) * 64 + 4 * hh - (qpos0 + r); \
            _Pragma("unroll") for (int i = 0; i < 16; ++i) { const int d0 = _kb + (i & 3) + 8 * (i >> 2), d1 = d0 + 32; \
                if (d0 > 128 || d0 < -128) C0[i] = -INFINITY; if (d1 > 128 || d1 < -128) C1[i] = -INFINITY; } } } \
        float mx = 0.f, mb = 0.f; \
        if (hasn) { const LAS unsigned char* _kp = Kb + ((buf) ^ 1) * KBUF + r * KP + hh * 16; const float _cv = -m_run; \
            _Pragma("unroll") for (int i = 0; i < 16; ++i) { N0[i] = _cv; N1[i] = _cv; } \
            bf16x8 _ka = *(const LAS bf16x8*)(_kp), _kb2 = *(const LAS bf16x8*)(_kp + 32 * KP); \
              \
            if ((it) + 2 < ntot) ATT_KSTORE(kr0_, kr1_, buf); ATT_VSTORE(vr_, (buf) ^ 1); \
            if ((it) + 4 < ntot) ATT_KLOAD(kr0_, kr1_, (it) + 4); if ((it) + 3 < ntot) ATT_VLOAD(vr_, (it) + 3); SBAR(); \
            _Pragma("unroll") for (int s = 0; s < NS; ++s) { bf16x8 _na = _ka, _nb = _kb2; \
                if (s + 1 < NS) { _na = *(const LAS bf16x8*)(_kp + (s + 1) * 32); _nb = *(const LAS bf16x8*)(_kp + 32 * KP + (s + 1) * 32); } \
                N0 = __builtin_amdgcn_mfma_f32_32x32x16_bf16(_ka, qf[s], N0, 0, 0, 0); ATT_RM(C0, C1, 3 * s); ATT_RM(C0, C1, 3 * s + 1); asm volatile("" : "+v"(mx), "+v"(mb)); SBAR(); \
                N1 = __builtin_amdgcn_mfma_f32_32x32x16_bf16(_kb2, qf[s], N1, 0, 0, 0); ATT_RM(C0, C1, 3 * s + 2); asm volatile("" : "+v"(mx), "+v"(mb)); SBAR(); \
                _ka = _na; _kb2 = _nb; } \
            _Pragma("unroll") for (int i = 3 * NS; i < 15; ++i) ATT_RM(C0, C1, i); \
        } else { _Pragma("unroll") for (int i = 0; i < 15; ++i) ATT_RM(C0, C1, i); } \
        mx = fmaxf(mx, mb); \
        { auto rr = __builtin_amdgcn_permlane32_swap(__float_as_uint(mx), __float_as_uint(mx), false, false); mx = fmaxf(__uint_as_float(rr[0]), __uint_as_float(rr[1])); } \
        float d_nxt = 0.f; \
        if (__any(mx > d_cur)) { const float dl = fmaxf(mx - d_cur, 0.f); const float alpha = __builtin_amdgcn_exp2f(-dl); m_run += dl; d_cur += dl; d_nxt = dl; \
            _Pragma("unroll") for (int i = 0; i < 16; ++i) { ot0[i] *= alpha; ot1[i] *= alpha; ol[i] *= alpha; } } \
        if (__any(d_cur != 0.f)) { _Pragma("unroll") for (int i = 0; i < 16; ++i) { C0[i] -= d_cur; C1[i] -= d_cur; } } \
        d_cur = d_nxt; \
        { const LAS unsigned char* _vp = Vb + (buf) * VBUF + r * VP + hh * 8; u32x4 pw[4]; bf16x8 _a0, _a1; \
          ATT_VFRAG(_a0, _a1, _vp, 0); ATT_EXP4(C0, C1, 0, 0); ATT_EXP4(C0, C1, 0, 1); ATT_CVT4(C0, C1, 0); SBAR(); \
          _Pragma("unroll") for (int g = 0; g < 4; ++g) { bf16x8 _n0 = _a0, _n1 = _a1; const bf16x8 pb = __builtin_bit_cast(bf16x8, pw[g]); \
            if (g + 1 < 4) ATT_VFRAG(_n0, _n1, _vp, g + 1); \
            ot0 = __builtin_amdgcn_mfma_f32_32x32x16_bf16(_a0, pb, ot0, 0, 0, 0); if (g + 1 < 4) ATT_EXP4(C0, C1, g + 1, 0); SBAR(); \
            ot1 = __builtin_amdgcn_mfma_f32_32x32x16_bf16(_a1, pb, ot1, 0, 0, 0); if (g + 1 < 4) ATT_EXP4(C0, C1, g + 1, 1); SBAR(); \
            ol = __builtin_amdgcn_mfma_f32_32x32x16_bf16(ones, pb, ol, 0, 0, 0); if (g + 1 < 4) ATT_CVT4(C0, C1, g + 1); SBAR(); \
            _a0 = _n0; _a1 = _n1; } } \
        __syncthreads(); } while (0)
    for (int it = 0; it < ntot; it += 2) {
        ATT_STEP(sa0, sa1, sb0, sb1, it, 0, kA0, kA1, vA);
        ATT_STEP(sb0, sb1, sa0, sa1, it + 1, 1, kB0, kB1, vB);
    }
#undef ATT_STEP
#undef ATT_RM
#undef ATT_EXP4
#undef ATT_CVT4
#undef ATT_VFRAG
#undef SBAR
#undef ATT_ROWMAX
#undef ATT_KLOAD
#undef ATT_VLOAD
#undef ATT_KSTORE
#undef ATT_VSTORE
#undef ATT_QK
#undef ATT_LOAD
#undef ATT_STORE
    float l_run = ol[0];
    if (SINK) { const float mnew = fmaxf(m_run, sink2); const float alpha = __builtin_amdgcn_exp2f(m_run - mnew);
        l_run = l_run * alpha + __builtin_amdgcn_exp2f(sink2 - mnew);
#pragma unroll
        for (int i = 0; i < 16; ++i) { ot0[i] *= alpha; ot1[i] *= alpha; } }
    const float inv = A8_SCALE / l_run;
    unsigned w0[4], w1[4];
#pragma unroll
    for (int g = 0; g < 4; ++g) { w0[g] = fp8x4(ot0[4 * g] * inv, ot0[4 * g + 1] * inv, ot0[4 * g + 2] * inv, ot0[4 * g + 3] * inv);
                                  w1[g] = fp8x4(ot1[4 * g] * inv, ot1[4 * g + 1] * inv, ot1[4 * g + 2] * inv, ot1[4 * g + 3] * inv); }
#define ATT_SW(a, b) do { auto _r = __builtin_amdgcn_permlane32_swap(a, b, false, false); a = _r[0]; b = _r[1]; } while (0)
    ATT_SW(w0[0], w0[1]); ATT_SW(w0[2], w0[3]); ATT_SW(w1[0], w1[1]); ATT_SW(w1[2], w1[3]);
    ATT_SW(w0[0], w0[2]); ATT_SW(w0[1], w0[3]); ATT_SW(w1[0], w1[2]); ATT_SW(w1[1], w1[3]);
#undef ATT_SW
    unsigned char* op = orow0 + (size_t)r * opitch + 16 * hh;
    *(u32x4*)op = (u32x4){w0[0], w0[1], w0[2], w0[3]}; *(u32x4*)(op + 32) = (u32x4){w1[0], w1[1], w1[2], w1[3]};
}

struct Params {
    const float* in[29];
    float* out; unsigned char* ws;
    int ph_lo, ph_hi, use_bar, pad;
};
enum { I_X = 0, I_C, I_CTX, I_CCTX, I_WMOD, I_BMOD, I_GMIX, I_GFFN, I_WIN, I_GQ, I_GKV, I_WUQ, I_WUKV, I_WPOOL, I_PSCALE, I_SINK, I_WBRM, I_WBRP, I_WBRS, I_WOUT,
       I_WROUTER, I_RBIAS, I_WEG, I_WEU, I_WED, I_WSG, I_WSU, I_WSD, I_GFINAL };
constexpr int LDS_MISC = 131072;
constexpr int LDS_PTRS = LDS_MISC + 16;
constexpr int LDS_SCR = LDS_MISC + 512;
constexpr int LDS_BYTES = 131072 + 16384;
struct Frame {
    LAS unsigned char* lds; int tid, lane, wid, G, bid;
    unsigned char* ws; unsigned char* act;
    __device__ __forceinline__ const float* in(int i) const { const LAS unsigned* q = (const LAS unsigned*)(lds + LDS_PTRS) + 2 * i;
        const unsigned lo = __builtin_amdgcn_readfirstlane(q[0]), hi = __builtin_amdgcn_readfirstlane(q[1]); return (const float*)(const __attribute__((address_space(1))) float*)(((unsigned long long)hi << 32) | lo); }
    __device__ __forceinline__ float* outp() const { return (float*)in(29); }
    __device__ __forceinline__ float* mod(int l, int mr, int chunk) const { return (float*)(ws + WS_MOD) + ((size_t)(l * 5 + mr) * 6 + chunk) * 1024; }
    __device__ __forceinline__ unsigned char* wsm(int l) const { return ws + WS_WSM + (size_t)l * WSM_LAYER; }
};
constexpr int NTHREADS = 512;

struct ConvJob { const float* src; const float* rs; bf16_t* dst; int ldsrc, k0, n0, nvalid, lddst, drow0, lo, f8; float mul; };
__device__ __forceinline__ ConvJob mkjob(const float* src, int ldsrc, int k0, int n0, int nvalid, const float* rs, bf16_t* dst, int lddst, int drow0) {
    ConvJob j; j.src = src; j.rs = rs; j.dst = dst; j.ldsrc = ldsrc; j.k0 = k0; j.n0 = n0; j.nvalid = nvalid; j.lddst = lddst; j.drow0 = drow0; j.lo = 0; j.f8 = 0; j.mul = 1.0f; return j; }
struct ConvRegs { f32x4 v[4][2]; };
__device__ __forceinline__ void conv_load1(const Frame& F, const ConvJob& J, f32x4 (&v)[2]) {
    const int kp = F.tid >> 4, j4 = (F.tid & 15) * 4;
#pragma unroll
    for (int h = 0; h < 2; ++h) { f32x4 x = {0.f, 0.f, 0.f, 0.f};
        if (J.src != nullptr && J.n0 + j4 < J.nvalid) x = __builtin_nontemporal_load((const f32x4*)(J.src + (size_t)(J.k0 + 2 * kp + h) * J.ldsrc + J.n0 + j4));
        v[h] = x; }
}
__device__ __forceinline__ void conv_lds1(const Frame& F, const ConvJob& J, const f32x4 (&v)[2], int q) {
    const int kp = F.tid >> 4, j4 = (F.tid & 15) * 4;
    const float s0 = (J.rs ? J.rs[J.k0 + 2 * kp] : 1.0f) * J.mul, s1 = (J.rs ? J.rs[J.k0 + 2 * kp + 1] : 1.0f) * J.mul;
    LAS unsigned* t = (LAS unsigned*)F.lds + q * 64 * 33 + j4 * 33 + kp;
#pragma unroll
    for (int e = 0; e < 4; ++e) { float a0 = v[0][e] * s0, a1 = v[1][e] * s1;
        if (J.lo) { a0 -= bf2f(f2bf(a0)); a1 -= bf2f(f2bf(a1)); }
        t[e * 33] = J.f8 ? (unsigned)__builtin_amdgcn_cvt_pk_fp8_f32(a0, a1, 0, false) : cvtpk(a0, a1); }
}
__device__ __forceinline__ void conv_store1(const Frame& F, const ConvJob& J, int q) {
    const int j = F.tid >> 3, q8 = F.tid & 7;
    const LAS unsigned* t = (const LAS unsigned*)F.lds + q * 64 * 33 + j * 33 + 4 * q8;
    u32x4 w; w.x = t[0]; w.y = t[1]; w.z = t[2]; w.w = t[3];
    if (J.f8) { u32x2 b; b.x = (w.x & 0xffffu) | (w.y << 16); b.y = (w.z & 0xffffu) | (w.w << 16);
        *(u32x2*)((unsigned char*)J.dst + (size_t)(J.drow0 + j) * J.lddst + J.k0 + 8 * q8) = b; }
    else *(u32x4*)(J.dst + (size_t)(J.drow0 + j) * J.lddst + J.k0 + 8 * q8) = w;
}
__device__ __forceinline__ void conv_load4(const Frame& F, const ConvJob& J0, const ConvJob& J1, const ConvJob& J2, const ConvJob& J3, ConvRegs& R) {
    conv_load1(F, J0, R.v[0]); conv_load1(F, J1, R.v[1]); conv_load1(F, J2, R.v[2]); conv_load1(F, J3, R.v[3]); }
__device__ __forceinline__ void conv_finish4(const Frame& F, const ConvJob& J0, const ConvJob& J1, const ConvJob& J2, const ConvJob& J3, const ConvRegs& R) {
    conv_lds1(F, J0, R.v[0], 0); conv_lds1(F, J1, R.v[1], 1); conv_lds1(F, J2, R.v[2], 2); conv_lds1(F, J3, R.v[3], 3);
    __syncthreads();
    conv_store1(F, J0, 0); conv_store1(F, J1, 1); conv_store1(F, J2, 2); conv_store1(F, J3, 3);
    __syncthreads();
}
constexpr int CT_IN = 0, CT_G8 = 16 * 48, CT_I8 = 16 * 32, CT_UQ = 6 * 12, CT_UKV = 4 * 16, CT_BR = 8 * 16, CT_OUT = 16 * 16, CT_RS = 16 * 12, CT_SD = 4 * 16;
constexpr int CT_SMALL = CT_IN + CT_G8 + CT_I8 + CT_UQ + CT_UKV + 2 * CT_BR + CT_OUT + CT_RS + CT_SD;
static_assert(CT_SMALL % 4 == 0, "conversion jobs are taken four at a time");
__device__ __forceinline__ ConvJob conv_small_job(const Frame& F, int l, int id) {
    unsigned char* W = F.wsm(l);
    if (id < CT_IN) { const int kt = id / 32, nt = id % 32;
        return mkjob(F.in(I_WIN) + (size_t)l * 1024 * NIN, NIN, kt * 64, nt * 64, NIN, nullptr, (bf16_t*)(W + WO_IN), 1024, nt * 64); }
    id -= CT_IN;
    if (id < CT_G8) { const int kt = id / 48, j = id % 48;
        ConvJob cj = mkjob(F.in(I_WIN) + (size_t)l * 1024 * NIN, NIN, kt * 64, OFF_GL + 64 * j, NIN, nullptr, (bf16_t*)(W + WO_G8), 1024, 64 * j); cj.f8 = 1; cj.mul = -W8_SCALE * LOG2E; return cj; }
    id -= CT_G8;
    if (id < CT_I8) { const int kt = id / 32, nt = id % 32;
        ConvJob cj = mkjob(F.in(I_WIN) + (size_t)l * 1024 * NIN, NIN, kt * 64, nt * 64, NIN, nullptr, (bf16_t*)(W + WO_I8), 1024, nt * 64); cj.f8 = 1; cj.mul = W8_SCALE; return cj; }
    id -= CT_I8;
    if (id < CT_UQ) { const int kt = id / 12, nt = id % 12;
        ConvJob j = mkjob(F.in(I_WUQ) + (size_t)l * 384 * 768, 768, kt * 64, nt * 64, 768, F.in(I_GQ) + l * 384, (bf16_t*)(W + WO_UQ), 384, nt * 64); j.mul = MLA_QSCALE; return j; }
    id -= CT_UQ;
    if (id < CT_UKV) { const int kt = id / 16, nt = id % 16;
        return mkjob(F.in(I_WUKV) + (size_t)l * 256 * 1024, 1024, kt * 64, nt * 64, 1024, F.in(I_GKV) + l * 256, (bf16_t*)(W + ((nt & 1) ? WO_V : WO_K)), 256, (nt >> 1) * 64); }
    id -= CT_UKV;
    if (id < CT_BR) { const int kt = id / 16, nt = id % 16;
        ConvJob cj = mkjob(F.in(I_WBRM) + (size_t)l * 512 * 1024, 1024, kt * 64, nt * 64, 1024, nullptr, (bf16_t*)(W + WO_BRM), 512, nt * 64); cj.f8 = 1; cj.mul = W8_SCALE; return cj; }
    id -= CT_BR;
    if (id < CT_BR) { const int kt = id / 16, nt = id % 16;
        ConvJob cj = mkjob(F.in(I_WBRS) + (size_t)l * 512 * 1024, 1024, kt * 64, nt * 64, 1024, nullptr, (bf16_t*)(W + WO_BRS), 512, nt * 64); cj.f8 = 1; cj.mul = W8_SCALE; return cj; }
    id -= CT_BR;
    if (id < CT_OUT) { const int kt = id / 16, nt = id % 16;
        return mkjob(F.in(I_WOUT) + (size_t)l * 1024 * 1024, 1024, kt * 64, nt * 64, 1024, nullptr, (bf16_t*)(W + WO_OUT), 1024, nt * 64); }
    id -= CT_OUT;
    if (id < CT_RS) { const int kt = id / 12, rt = id % 12;
        const float* src = nullptr; int ld = 256, n0 = 0;
        if (rt < 8) { const int pn = rt >> 2, isup = (rt >> 1) & 1, sub = rt & 1; src = F.in(isup ? I_WSU : I_WSG) + (size_t)l * 1024 * 256; n0 = pn * 128 + sub * 64; }
        else if (rt == 8 || rt == 9) { src = F.in(I_WROUTER) + (size_t)l * 1024 * 64; ld = 64; n0 = 0; }
        ConvJob j = mkjob(src, ld, kt * 64, n0, ld, nullptr, (bf16_t*)(W + WO_RS), 1024, rt * 64); j.lo = (rt == 9) ? 1 : 0; return j; }
    id -= CT_RS;
    { const int kt = id / 16, nt = id % 16;
      return mkjob(F.in(I_WSD) + (size_t)l * 256 * 1024, 1024, kt * 64, nt * 64, 1024, nullptr, (bf16_t*)(W + WO_SD), 256, nt * 64); }
}
constexpr int CT_EXP = NEXP * 192;
constexpr int CV_G1 = 4;
constexpr int CV_G6 = 8;
constexpr int CV_G5 = (CT_EXP / 4) * 7 / 16;
__device__ __forceinline__ ConvJob conv_exp_job(const Frame& F, int l, int id) {
    const int e = id / 192, j = id % 192;
    if (j < 128) { const int isup = j >> 6, jj = j & 63, kt = jj >> 2, m = jj & 3;
        const float* src = F.in(isup ? I_WEU : I_WEG) + ((size_t)l * NEXP + e) * 1024 * 256;
        ConvJob cj = mkjob(src, 256, kt * 64, m * 64, 256, nullptr, (bf16_t*)(F.ws + WS_WGU + (size_t)e * 512 * 1024), 1024, (m >> 1) * 256 + isup * 128 + (m & 1) * 64);
        cj.f8 = 1; cj.mul = W8_SCALE; return cj;
    } else { const int jj = j - 128, kt = jj >> 4, nt = jj & 15;
        const float* src = F.in(I_WED) + ((size_t)l * NEXP + e) * 256 * 1024;
        ConvJob cj = mkjob(src, 1024, kt * 64, nt * 64, 1024, nullptr, (bf16_t*)(F.ws + WS_WDN + (size_t)e * 1024 * 256), 256, nt * 64);
        cj.f8 = 1; cj.mul = W8_SCALE; return cj; }
}
#define CONV_PIPE(NGROUPS, JOB, RANK, NWORK) do { int g = (RANK); if (g >= 0 && g < (NGROUPS)) { ConvRegs R; \
        { const int id = 4 * g; conv_load4(F, JOB(id), JOB(id + 1), JOB(id + 2), JOB(id + 3), R); } \
        for (;;) { const int gn = g + (NWORK); const bool more = gn < (NGROUPS); ConvRegs Rn; \
            if (more) { const int idn = 4 * gn; conv_load4(F, JOB(idn), JOB(idn + 1), JOB(idn + 2), JOB(idn + 3), Rn); } \
            { const int id = 4 * g; conv_finish4(F, JOB(id), JOB(id + 1), JOB(id + 2), JOB(id + 3), R); } \
            if (!more) break; R = Rn; g = gn; } } } while (0)
__device__ __forceinline__ void conv_small_all(const Frame& F, int l, int rank, int nwork) {
#define JOB_SMALL(id) conv_small_job(F, l, (id))
    CONV_PIPE(CT_SMALL / 4, JOB_SMALL, rank, nwork);
#undef JOB_SMALL
}
__device__ __forceinline__ void conv_exp_all(const Frame& F, int l, int rank, int nwork) {
#define JOB_EXP(id) conv_exp_job(F, l, (id))
    CONV_PIPE(CT_EXP / 4, JOB_EXP, rank, nwork);
#undef JOB_EXP
}
__device__ __forceinline__ void conv_exp_range(const Frame& F, int l, int g0, int ng, int rank, int nwork) {
#define JOB_EXPR(id) conv_exp_job(F, l, 4 * g0 + (id))
    CONV_PIPE(ng, JOB_EXPR, rank, nwork);
#undef JOB_EXPR
}
__device__ __forceinline__ void wcomb_job(const Frame& F, int l, int id) {
    const int j = id >> 4, n0 = (id & 15) * 64, tid = F.tid;
    LAS float* Pm = (LAS float*)F.lds;
    LAS float* Bm = Pm + 128 * 128;
    const float* wp = F.in(I_WPOOL) + ((size_t)l * 4 + j) * 128 * 128;
    const float* ps = F.in(I_PSCALE) + l * 512 + j * 128;
    const float* wb = F.in(I_WBRP) + ((size_t)l * 512 + j * 128) * 1024;
    for (int i = tid; i < 128 * 128; i += NTHREADS) Pm[i] = wp[i] * ps[i & 127];
    for (int i = tid; i < 128 * 64; i += NTHREADS) Bm[i] = wb[(size_t)(i >> 6) * 1024 + n0 + (i & 63)];
    __syncthreads();
    const int n = tid & 63, cg = tid >> 6;
    float a[16];
#pragma unroll
    for (int e = 0; e < 16; ++e) a[e] = 0.f;
    for (int d = 0; d < 128; ++d) { const float b = Bm[d * 64 + n];
#pragma unroll
        for (int e = 0; e < 16; ++e) a[e] = fmaf(Pm[(cg * 16 + e) * 128 + d], b, a[e]); }
    unsigned char* dst = F.wsm(l) + WO_COMB + (size_t)(n0 + n) * 512 + j * 128 + cg * 16;
#pragma unroll
    for (int e = 0; e < 16; ++e) a[e] *= W8_SCALE;
    *(u32x4*)dst = (u32x4){fp8x4(a[0], a[1], a[2], a[3]), fp8x4(a[4], a[5], a[6], a[7]), fp8x4(a[8], a[9], a[10], a[11]), fp8x4(a[12], a[13], a[14], a[15])};
    __syncthreads();
}
__device__ __forceinline__ void mod_job(const Frame& F, int id) {
    const int l = id / 96, n0 = (id % 96) * 64, tid = F.tid, n4 = tid & 15, kq = tid >> 4;
    const float* wm = F.in(I_WMOD) + (size_t)l * 1024 * 6144 + n0 + 4 * n4;
    LAS float* S = (LAS float*)F.lds;
    LAS float* R = S + 5 * 1024;
    for (int i = tid; i < 5 * 1024; i += NTHREADS) { const int r = i >> 10, k = i & 1023; const float cv = (r < 4) ? F.in(I_C)[r * 1024 + k] : F.in(I_CCTX)[k]; S[i] = cv * fast_sigmoid(cv); }
    __syncthreads();
    f32x4 a[5];
#pragma unroll
    for (int r = 0; r < 5; ++r) a[r] = (f32x4){0.f, 0.f, 0.f, 0.f};
    for (int kb = kq * 32; kb < kq * 32 + 32; kb += 16) {
        f32x4 w[16];
#pragma unroll
        for (int u = 0; u < 16; ++u) w[u] = __builtin_nontemporal_load((const f32x4*)(wm + (size_t)(kb + u) * 6144));
#pragma unroll
        for (int u = 0; u < 16; ++u) {
#pragma unroll
            for (int r = 0; r < 5; ++r) a[r] += w[u] * S[r * 1024 + kb + u]; }
    }
#pragma unroll
    for (int r = 0; r < 5; ++r) *(LAS f32x4*)(R + (kq * 5 + r) * 64 + 4 * n4) = a[r];
    __syncthreads();
    if (tid < 320) { const int r = tid >> 6, n = tid & 63; float sacc = 0.f;
#pragma unroll
        for (int g = 0; g < 32; ++g) sacc += R[(g * 5 + r) * 64 + n];
        const int col = n0 + n;
        ((float*)(F.ws + WS_MOD))[(size_t)(l * 5 + r) * 6144 + col] = sacc + F.in(I_BMOD)[l * 6144 + col]; }
    __syncthreads();
}
__device__ __forceinline__ void tab_job(const Frame& F) {
    float* tm = (float*)(F.ws + WS_TABM); float* ts = (float*)(F.ws + WS_TABS);
    for (int i = F.tid; i < 64 * 8 + 64 * 16; i += NTHREADS) {
        const bool mla = i < 512; const int ii = mla ? i : i - 512, nf = mla ? 8 : 16, pos = ii / nf, fi = ii % nf;
        const float invf = exp2f(-(float)fi / (float)nf * 13.287712379549449f);
        float s, c; sincos_small((float)pos * invf, s, c);
        float* tb = mla ? tm : ts; tb[pos * nf + fi] = c; tb[64 * nf + pos * nf + fi] = s;
    }
}
constexpr int P0_MOD = 192, P0_TAB = 1, P0_WCOMB = 2 * 64;
constexpr int P0_ITEMS = P0_MOD + P0_TAB + P0_WCOMB;
__device__ __forceinline__ void setup_layer(const Frame& F, int l, int rank, int nwork) {
    if (rank < 0) return;
    constexpr int NIT = P0_MOD / 2 + P0_WCOMB / 2 + 1;
    for (int it = nwork - 1 - rank; it < NIT; it += nwork) {
        int id = it;
        if (id < P0_MOD / 2) { mod_job(F, l * (P0_MOD / 2) + id); continue; } id -= P0_MOD / 2;
        if (id < P0_WCOMB / 2) { wcomb_job(F, l, id); continue; }
        if (l == 0) tab_job(F);
    }
    conv_small_all(F, l, rank, nwork);
}
__device__ __forceinline__ void phase_p0(const Frame& F) { setup_layer(F, 0, F.bid, F.G); }

struct RouteTabs { const LAS int* off; const LAS int* tile_e; const LAS int* tile_base; const LAS int* tile_nv; int ntiles; };
__device__ __forceinline__ RouteTabs route_tables(const Frame& F, int l, bool tiles) {
    LAS int* cn = (LAS int*)(F.lds + LDS_SCR); LAS int* off = cn + 64; LAS int* te = cn + 192; LAS int* tb = te + MAXTILES; LAS int* tn = tb + MAXTILES;
    const unsigned* cnt = (const unsigned*)(F.ws + WS_CTL) + CW_CNT + l * 64;
    __syncthreads();
    if (F.tid < 64) cn[F.tid] = (int)ld_ctl(cnt + F.tid);
    __syncthreads();
    if (F.tid == 0) { int o = 0; for (int e = 0; e < 64; ++e) { off[e] = o; o += (cn[e] + 255) & ~255; } off[64] = o; }
    __syncthreads();
    RouteTabs r; r.off = off; r.tile_e = te; r.tile_base = tb; r.tile_nv = tn; r.ntiles = off[64] >> 8;
    if (tiles) { for (int tl = F.tid; tl < r.ntiles; tl += NTHREADS) { int e = 0; for (int q = 1; q < 64; ++q) e += (off[q] <= tl * 256) ? 1 : 0;
                     const int first = tl * 256 - off[e]; te[tl] = e; tb[tl] = e * TT + first; tn[tl] = cn[e] - first; }
                 __syncthreads(); }
    return r;
}

__device__ __forceinline__ const float* xin_row(const Frame& F, int l, int t) {
    (void)l;
    return t < TL ? F.in(I_X) + (size_t)t * 1024 : F.in(I_CTX) + (size_t)(t - TL) * 1024;
}
__device__ __forceinline__ unsigned dpp_xor1(unsigned x) { return (unsigned)__builtin_amdgcn_update_dpp(0, (int)x, 0xB1, 0xF, 0xF, true); }
__device__ __forceinline__ void store_pair_b16(bf16_t* row, int i0, int i1, const u32x2& w0, const u32x2& w1, int lane) {
    const bool odd = lane & 1; const u32x2 snd = odd ? w0 : w1; const u32x2 rcv = (u32x2){dpp_xor1(snd.x), dpp_xor1(snd.y)};
    const u32x4 o = odd ? (u32x4){rcv.x, rcv.y, w1.x, w1.y} : (u32x4){w0.x, w0.y, rcv.x, rcv.y};
    *(u32x4*)(row + 256 * (odd ? i1 : i0) + 4 * (lane & ~1)) = o; }
__device__ __forceinline__ void store_pair_b8(unsigned char* row, int i0, int i1, unsigned w0, unsigned w1, int lane) {
    const bool odd = lane & 1; const unsigned rcv = dpp_xor1(odd ? w0 : w1);
    const u32x2 o = odd ? (u32x2){rcv, w1} : (u32x2){w0, rcv};
    *(u32x2*)(row + 256 * (odd ? i1 : i0) + 4 * (lane & ~1)) = o; }
__device__ __forceinline__ void norm_mod_store(const f32x4 (&v)[4], const float* g, const float* sc, const float* sh, bf16_t* dst, int lane, unsigned char* dst8 = nullptr) {
    float ss = 0.f;
#pragma unroll
    for (int i = 0; i < 4; ++i) ss += v[i][0] * v[i][0] + v[i][1] * v[i][1] + v[i][2] * v[i][2] + v[i][3] * v[i][3];
    ss = wave_sum(ss);
    const float rstd = rsqrtf(ss * (1.0f / 1024.0f) + NORM_EPS);
    u32x2 wb[4]; unsigned w8[4];
#pragma unroll
    for (int i = 0; i < 4; ++i) { const int c = 4 * lane + 256 * i;
        const f32x4 gv = *(const f32x4*)(g + c), sv = *(const f32x4*)(sc + c), hv = *(const f32x4*)(sh + c);
        f32x4 o;
#pragma unroll
        for (int e = 0; e < 4; ++e) o[e] = v[i][e] * rstd * gv[e] * (1.0f + sv[e]) + hv[e];
        wb[i].x = cvtpk(o[0], o[1]); wb[i].y = cvtpk(o[2], o[3]);
        { int q = 0; q = __builtin_amdgcn_cvt_pk_fp8_f32(o[0] * F8_SCALE, o[1] * F8_SCALE, q, false); q = __builtin_amdgcn_cvt_pk_fp8_f32(o[2] * F8_SCALE, o[3] * F8_SCALE, q, true); w8[i] = (unsigned)q; } }
    if (dst)  { store_pair_b16(dst, 0, 1, wb[0], wb[1], lane); store_pair_b16(dst, 2, 3, wb[2], wb[3], lane); }
    if (dst8) { store_pair_b8(dst8, 0, 1, w8[0], w8[1], lane); store_pair_b8(dst8, 2, 3, w8[2], w8[3], lane); }
}
__device__ __forceinline__ void phase_e1(const Frame& F) {
    const float* g = F.in(I_GMIX);
    for (int t = F.bid * 8 + F.wid; t < TT; t += F.G * 8) {
        const float* xr = xin_row(F, 0, t); f32x4 v[4];
#pragma unroll
        for (int i = 0; i < 4; ++i) v[i] = __builtin_nontemporal_load((const f32x4*)(xr + 4 * F.lane + 256 * i));
        const int mr = tok_modrow(t);
        norm_mod_store(v, g, F.mod(0, mr, 1), F.mod(0, mr, 0), nullptr, F.lane, F.ws + WS_H8 + (size_t)t * 1024);
    }
}
__device__ __forceinline__ void phase_e5(const Frame& F, int l, int Te) {
    const float* g = F.in(I_GFFN) + l * 1024;
    bf16_t* Fb = (bf16_t*)(F.act + A_F);
    unsigned char* F8 = F.act + A_F8;
    if (F.bid == 0) { for (int i = F.tid; i < 512; i += NTHREADS) ((unsigned*)(Fb + (size_t)TT * 1024))[i] = 0u;
        for (int i = F.tid; i < 256; i += NTHREADS) ((unsigned*)(F8 + (size_t)TT * 1024))[i] = 0u; }
    for (int t = F.bid * 8 + F.wid; t < Te; t += F.G * 8) {
        const int mr = tok_modrow(t); const bf16_t* xr = (const bf16_t*)(F.ws + WS_X) + (size_t)t * 1024; f32x4 v[4];
#pragma unroll
        for (int i = 0; i < 4; ++i) { const u32x2 xw = *(const u32x2*)(xr + 4 * F.lane + 256 * i); v[i] = (f32x4){bflo(xw.x), bfhi(xw.x), bflo(xw.y), bfhi(xw.y)}; }
        norm_mod_store(v, g, F.mod(l, mr, 4), F.mod(l, mr, 3), Fb + (size_t)t * 1024, F.lane, F8 + (size_t)t * 1024);
    }
}
__device__ __forceinline__ void phase_e6(const Frame& F, int l, int Te) {
    const unsigned char* Y = F.act + A_YH0; const unsigned char* YS = F.act + A_YS;
    const int* toke = (const int*)(F.ws + WS_TOKE); const int* tokp = (const int*)(F.ws + WS_TOKP); const RouteTabs rt = route_tables(F, l, false);
    const bool last = (l == DEPTH - 1);
    for (int t = F.bid * 8 + F.wid; t < Te; t += F.G * 8) {
        const int c = 16 * F.lane; const int mr = tok_modrow(t);
        bf16_t* xo = (bf16_t*)(F.ws + WS_X) + (size_t)t * 1024 + c;
        float a[16];
#pragma unroll
        for (int i = 0; i < 16; ++i) a[i] = 0.f;
#pragma unroll
        for (int k = 0; k < 8; ++k) { const int rw = rt.off[toke[t * 8 + k]] + tokp[t * 8 + k]; const u32x4 w = *(const u32x4*)(Y + (size_t)rw * 1024 + c);
#pragma unroll
            for (int q = 0; q < 4; ++q) { const f32x2v lo = __builtin_amdgcn_cvt_pk_f32_fp8((int)w[q], false), hi = __builtin_amdgcn_cvt_pk_f32_fp8((int)w[q], true);
                a[4 * q] += lo.x; a[4 * q + 1] += lo.y; a[4 * q + 2] += hi.x; a[4 * q + 3] += hi.y; } }
        { const u32x4 w = *(const u32x4*)(YS + (size_t)t * 1024 + c);
#pragma unroll
          for (int q = 0; q < 4; ++q) { const f32x2v lo = __builtin_amdgcn_cvt_pk_f32_fp8((int)w[q], false), hi = __builtin_amdgcn_cvt_pk_f32_fp8((int)w[q], true);
              a[4 * q] += lo.x; a[4 * q + 1] += lo.y; a[4 * q + 2] += hi.x; a[4 * q + 3] += hi.y; }
#pragma unroll
          for (int i = 0; i < 16; ++i) a[i] *= (1.0f / Y8_SCALE); }
        const float* gt = F.mod(l, mr, 5) + c;
        float x[16]; float ss = 0.f;
        { float xin[16]; unpack8(*(const u32x4*)xo, *(float(*)[8])&xin[0]); unpack8(*(const u32x4*)(xo + 8), *(float(*)[8])&xin[8]);
#pragma unroll
          for (int q = 0; q < 4; ++q) { const f32x4 gv = *(const f32x4*)(gt + 4 * q);
#pragma unroll
            for (int e = 0; e < 4; ++e) { x[4 * q + e] = xin[4 * q + e] + gv[e] * a[4 * q + e]; ss += x[4 * q + e] * x[4 * q + e]; } } }
        ss = wave_sum(ss);
        const float rstd = rsqrtf(ss * (1.0f / 1024.0f) + NORM_EPS);
        if (last) {
            if (t < TL) { const float* gf = F.in(I_GFINAL) + c; float* o = F.outp() + (size_t)t * 1024 + c;
#pragma unroll
                for (int q = 0; q < 4; ++q) { const f32x4 gv = *(const f32x4*)(gf + 4 * q); f32x4 ov;
#pragma unroll
                    for (int e = 0; e < 4; ++e) ov[e] = x[4 * q + e] * rstd * gv[e];
                    *(f32x4*)(o + 4 * q) = ov; } }
        } else {
            *(u32x4*)xo = packf8(*(const float(*)[8])&x[0]); *(u32x4*)(xo + 8) = packf8(*(const float(*)[8])&x[8]);
            const float* g = F.in(I_GMIX) + (l + 1) * 1024 + c; const float* sc = F.mod(l + 1, mr, 1) + c; const float* sh = F.mod(l + 1, mr, 0) + c;
            float o[16];
#pragma unroll
            for (int q = 0; q < 4; ++q) { const f32x4 gv = *(const f32x4*)(g + 4 * q), sv = *(const f32x4*)(sc + 4 * q), hv = *(const f32x4*)(sh + 4 * q);
#pragma unroll
                for (int e = 0; e < 4; ++e) o[4 * q + e] = x[4 * q + e] * rstd * gv[e] * (1.0f + sv[e]) + hv[e]; }
            { u32x4 w8;
#pragma unroll
              for (int q = 0; q < 4; ++q) { int w = 0; w = __builtin_amdgcn_cvt_pk_fp8_f32(o[4 * q] * F8_SCALE, o[4 * q + 1] * F8_SCALE, w, false); w = __builtin_amdgcn_cvt_pk_fp8_f32(o[4 * q + 2] * F8_SCALE, o[4 * q + 3] * F8_SCALE, w, true); w8[q] = (unsigned)w; }
              *(u32x4*)(F.ws + WS_H8 + (size_t)t * 1024 + c) = w8; }
        }
    }
}
__device__ __forceinline__ void rope8(float (&mine)[8], const float (&oth)[8], const float* cs, const float* sn, bool first) {
#pragma unroll
    for (int e = 0; e < 8; ++e) mine[e] = first ? (mine[e] * cs[e] - oth[e] * sn[e]) : (mine[e] * cs[e] + oth[e] * sn[e]);
}
__device__ __forceinline__ void phase_e3(const Frame& F) {
    const bf16_t* CQ = (const bf16_t*)(F.act + A_CQ); const bf16_t* CKV = (const bf16_t*)(F.act + A_CKV); const bf16_t* KR = (const bf16_t*)(F.act + A_KR);
    const bf16_t* U = (const bf16_t*)(F.act + A_U); const bf16_t* QSR = (const bf16_t*)(F.act + A_QSR); const bf16_t* KSR = (const bf16_t*)(F.act + A_KSR);
    bf16_t* CQN = (bf16_t*)(F.act + A_CQN); bf16_t* CKVN = (bf16_t*)(F.act + A_CKVN); unsigned char* POOL = F.act + A_POOL;
    bf16_t* QS = (bf16_t*)(F.act + A_QS); bf16_t* KS = (bf16_t*)(F.act + A_KS); bf16_t* KK = (bf16_t*)(F.act + A_K);
    const float* tabm = (const float*)(F.ws + WS_TABM); const float* tabs = (const float*)(F.ws + WS_TABS);
    const int lane = F.lane;
    for (int t = F.bid * 8 + F.wid; t < TT; t += F.G * 8) {
        const bool lat = t < TL; const int s = lat ? (t & 4095) : ((t - TL) & 255); const int L = lat ? SEQ : CTXL;
        const int prow = s >> 6, pcol = s & 63;
        const int kh = (lane & 31) >> 2, kq = lane & 3; const bf16_t* kr = KR + (size_t)t * 32;
        const u32x4 krm = *(const u32x4*)(kr + 8 * kq), kro = *(const u32x4*)(kr + 8 * (kq ^ 1));
        const int w = 2 << (lane >> 4); int lo = s - (w >> 1), hi = s + (w >> 1); lo = lo < 0 ? 0 : lo; hi = hi > L ? L : hi;
        const bf16_t* ub = U + (size_t)(t - s) * 512 + 8 * lane;
        u32x4 uw[16];
#pragma unroll
        for (int k = 0; k < 16; ++k) { const int q = lo + k; uw[k] = *(const u32x4*)(ub + (size_t)(q < hi ? q : s) * 512); }
        const u32x4 ume = *(const u32x4*)(ub + (size_t)s * 512);
        const int kl = lane & 15;
        const u32x4 ka = *(const u32x4*)(KSR + (size_t)t * 128 + 8 * kl), kb = *(const u32x4*)(KSR + (size_t)t * 128 + 8 * (kl ^ 2));
        { float a[8], b[8]; unpack8(krm, a); unpack8(kro, b);
          if (lat) { const int pos = (kq < 2) ? prow : pcol; rope8(a, b, tabm + pos * 8, tabm + 512 + pos * 8, (kq & 1) == 0); }
          if (lane < 32) *(u32x4*)(KK + (size_t)t * 768 + kh * 96 + 64 + 8 * kq) = packf8(a); }
        { float acc[8] = {0.f, 0.f, 0.f, 0.f, 0.f, 0.f, 0.f, 0.f};
#pragma unroll
          for (int k = 0; k < 16; ++k) { float a[8]; unpack8(uw[k], a); const float on = (lo + k < hi) ? 1.0f : 0.0f;
#pragma unroll
              for (int e = 0; e < 8; ++e) acc[e] = fmaf(a[e], on, acc[e]); }
          float me[8]; unpack8(ume, me);
          const float inv = 1.0f / (float)(hi - lo);
#pragma unroll
          for (int e = 0; e < 8; ++e) acc[e] = (acc[e] * inv - me[e]) * A8_SCALE;
          *(u32x2*)(POOL + (size_t)t * 512 + 8 * lane) = (u32x2){fp8x4s(acc[0], acc[1], acc[2], acc[3]), fp8x4s(acc[4], acc[5], acc[6], acc[7])}; }
        { float a[8], b[8]; unpack8(ka, a); unpack8(kb, b);
          if (lat) { const int qt = (kl & 7) >> 1, i0 = (kl & 1) * 8; const int pos = (qt < 2) ? prow : pcol;
              rope8(a, b, tabs + pos * 16 + i0, tabs + 1024 + pos * 16 + i0, (qt & 1) == 0); }
          if (lane < 16) *(u32x4*)(KS + (size_t)t * 128 + 8 * lane) = packf8(a); }
    }
}
__device__ __forceinline__ void phase_att(const Frame& F, int l) {
    const bool last = (l == DEPTH - 1);
    const bf16_t* Q = (const bf16_t*)(F.act + A_Q); const bf16_t* K = (const bf16_t*)(F.act + A_K); const bf16_t* VT = (const bf16_t*)(F.act + A_VT);
    const bf16_t* QS = (const bf16_t*)(F.act + A_QS); const bf16_t* KS = (const bf16_t*)(F.act + A_KS); const bf16_t* VST = (const bf16_t*)(F.act + A_VST);
    unsigned char* YM = F.act + A_YMLA; unsigned char* YW = F.act + A_YSWA;
    const int wid = F.wid;
    const int nper = F.G / 8;
    for (int v = F.bid / 8; v < 64; v += nper) {
        const int x = F.bid & 7, bh = x * 4 + (v >> 4), qb = v & 15, b = bh >> 3, h = bh & 7;
        const int row0 = b * SEQ + qb * 256 + 32 * wid;
        AttnSeg s0, s1;
        s0.k = K + (size_t)(TL + b * CTXL) * 768 + h * 96; s0.vt = VT + (size_t)(h * 64) * TT + TL + b * CTXL; s0.ntiles = 4; s0.kpos0 = 0;
        s1.k = K + (size_t)(b * SEQ) * 768 + h * 96;       s1.vt = VT + (size_t)(h * 64) * TT + b * SEQ;       s1.ntiles = 64; s1.kpos0 = 0;
        attn_unit<96, false, false, true>(F.lds, Q + (size_t)row0 * 768 + h * 96, 768, YM + (size_t)row0 * 512 + h * 64, 512, s0, s1, 768, TT, qb * 256 + 32 * wid, 0.f, (const float*)(F.ws + WS_TABM));
    }
    for (int u = F.bid; u < 512; u += F.G) {
        const int pair = u & 1, n = (u >> 1) & 31, kvh = (u >> 6) & 1, b = u >> 7;
        const int head = kvh * 4 + pair * 2 + (wid >> 2), tq = n * 128 + 32 * (wid & 3), row0 = b * SEQ + tq;
        const int nb0 = n > 0 ? n - 1 : 0, nb1 = n < 31 ? n + 1 : 31;
        AttnSeg s0, s1;
        s0.k = KS + (size_t)(TL + b * CTXL) * 128 + kvh * 64; s0.vt = VST + (size_t)(kvh * 64) * TT + TL + b * CTXL; s0.ntiles = 4; s0.kpos0 = 0;
        s1.k = KS + (size_t)(b * SEQ + nb0 * 128) * 128 + kvh * 64; s1.vt = VST + (size_t)(kvh * 64) * TT + b * SEQ + nb0 * 128; s1.ntiles = 2 * (nb1 - nb0 + 1); s1.kpos0 = nb0 * 128;
        const float sink2 = F.in(I_SINK)[l * 8 + head] * LOG2E;
        attn_unit<64, true, true, false, true>(F.lds, QS + (size_t)row0 * 512 + head * 64, 512, YW + (size_t)row0 * 512 + head * 64, 512, s0, s1, 128, TT, tq, sink2, (const float*)(F.ws + WS_TABS));
    }
    if (!last) {
        AttnSeg s1; s1.k = nullptr; s1.vt = nullptr; s1.ntiles = 0; s1.kpos0 = 0;
        for (int u = F.bid; u < 32; u += F.G) {
            const int b = u >> 3, h = u & 7, row0 = TL + b * CTXL + 32 * wid;
            AttnSeg s0; s0.k = K + (size_t)(TL + b * CTXL) * 768 + h * 96; s0.vt = VT + (size_t)(h * 64) * TT + TL + b * CTXL; s0.ntiles = 4; s0.kpos0 = 0;
            attn_unit<96, false, false, false>(F.lds, Q + (size_t)row0 * 768 + h * 96, 768, YM + (size_t)row0 * 512 + h * 64, 512, s0, s1, 768, TT, 0, 0.f, nullptr);
        }
        for (int u = F.G - 1 - F.bid; u < 32; u += F.G) {
            const int b = u >> 3, head = u & 7, kvh = head >> 2, row0 = TL + b * CTXL + 32 * wid;
            AttnSeg s0; s0.k = KS + (size_t)(TL + b * CTXL) * 128 + kvh * 64; s0.vt = VST + (size_t)(kvh * 64) * TT + TL + b * CTXL; s0.ntiles = 4; s0.kpos0 = 0;
            const float sink2 = F.in(I_SINK)[l * 8 + head] * LOG2E;
            attn_unit<64, false, true, false, true>(F.lds, QS + (size_t)row0 * 512 + head * 64, 512, YW + (size_t)row0 * 512 + head * 64, 512, s0, s1, 128, TT, 0, sink2, nullptr);
        }
    }
}

__device__ __forceinline__ float rdlane_f(float v, int l) { return __int_as_float(__builtin_amdgcn_readlane(__float_as_int(v), l)); }
__device__ __forceinline__ void phase_r1(const Frame& F, int l, int Te) {
    LAS unsigned char* sb = F.lds + LDS_SCR;
    LAS int* lcount = (LAS int*)sb; LAS int* lbase = lcount + 64; LAS int* se = lbase + 64;
    const int TPB = (Te + F.G - 1) / F.G;
    LAS int* sp = se + 80 * 8; LAS float* sw = (LAS float*)(sp + 80 * 8);
    const float* logits = (const float*)(F.ws + WS_LOGIT); const float* logits2 = (const float*)(F.ws + WS_LOGIT2);
    unsigned* cnt = (unsigned*)(F.ws + WS_CTL) + CW_CNT + l * 64;
    const int lane = F.lane, g = lane >> 3;
    if (F.tid < 64) lcount[F.tid] = 0;
    __syncthreads();
    const int t0 = F.bid * TPB;
    const float bias = F.in(I_RBIAS)[l * 64 + lane];
    for (int ti = F.wid; ti < TPB; ti += 8) {
        const int t = t0 + ti; if (t >= Te) break;
        const float score = 1.0f / (1.0f + expf(-(logits[(size_t)t * 64 + lane] + logits2[(size_t)t * 64 + lane])));
        const float selv = score + bias;
        float m1 = selv; m1 = fmaxf(m1, __shfl_xor(m1, 1)); m1 = fmaxf(m1, __shfl_xor(m1, 2)); m1 = fmaxf(m1, __shfl_xor(m1, 4));
        const unsigned long long eq = __ballot(selv == m1);
        const int first = __builtin_ctz((unsigned)((eq >> (g * 8)) & 0xffull));
        float m2 = ((lane & 7) == first) ? -INFINITY : selv; m2 = fmaxf(m2, __shfl_xor(m2, 1)); m2 = fmaxf(m2, __shfl_xor(m2, 2)); m2 = fmaxf(m2, __shfl_xor(m2, 4));
        const float gs = m1 + m2;
        int grank = 0;
#pragma unroll
        for (int g2 = 0; g2 < 8; ++g2) { const float o = rdlane_f(gs, g2 * 8); grank += (o > gs || (o == gs && g2 < g)) ? 1 : 0; }
        const bool gsel = grank < 4;
        const float ms = gsel ? selv : -INFINITY;
        int rnk = 0;
#pragma unroll
        for (int e2 = 0; e2 < 64; ++e2) { const float o = rdlane_f(ms, e2); rnk += (o > ms || (o == ms && e2 < lane)) ? 1 : 0; }
        const bool chosen = gsel && rnk < 8;
        const float wsum = wave_sum(chosen ? score : 0.f);
        if (chosen) { const int lp = atomicAdd((int*)&lcount[lane], 1);
            se[ti * 8 + rnk] = lane; sp[ti * 8 + rnk] = lp; sw[ti * 8 + rnk] = score / wsum * 2.5f; }
    }
    __syncthreads();
    if (F.tid < 64) lbase[F.tid] = (int)xb_add(cnt + F.tid, (unsigned)lcount[F.tid]);
    __syncthreads();
    int* toke = (int*)(F.ws + WS_TOKE); int* tokp = (int*)(F.ws + WS_TOKP); int* ptok = (int*)(F.ws + WS_PTOK); float* pwt = (float*)(F.ws + WS_PWT);
    for (int i = F.tid; i < TPB * 8; i += NTHREADS) { const int t = t0 + (i >> 3); if (t >= Te) break;
        const int e = se[i], pos = lbase[e] + sp[i]; toke[(size_t)t * 8 + (i & 7)] = e; tokp[(size_t)t * 8 + (i & 7)] = pos;
        ptok[(size_t)e * TT + pos] = t; pwt[(size_t)e * TT + pos] = sw[i]; }
    __syncthreads();
}
__device__ __forceinline__ pg8::Dense dense(const Frame& F, const void* A, const void* Bt, int M, int N, int K, int rot) {
    pg8::Dense d; d.A = (const bf16_t*)A; d.Bt = (const bf16_t*)Bt; d.nM = M / 256; d.nN = N / 256; d.K = K; d.G = F.G; d.c = (F.bid + F.G - (rot % F.G)) % F.G; return d;
}
__device__ __forceinline__ void phase_g1(const Frame& F, int l) {
    unsigned char* W = F.wsm(l);
    { EpiGate8 E; E.gates = F.act + A_GATES;
      pg8::DenseT<true, 0x7A7A7A7A, 0x7A7A7A7A> d; d.A = (const bf16_t*)(F.ws + WS_H8); d.Bt = (const bf16_t*)(W + WO_G8); d.nM = TT / 256; d.nN = 3072 / 256; d.K = 512; d.G = F.G; d.c = F.bid;
      pg8::gemm_phase(F.lds, d, E); }
    { EpiSeg E; E.act = F.act;
      pg8::DenseT<true, 0x7A7A7A7A, 0x7A7A7A7A> d; d.A = (const bf16_t*)(F.ws + WS_H8); d.Bt = (const bf16_t*)(W + WO_I8); d.nM = TT / 256; d.nN = 8; d.K = 512; d.G = F.G; d.c = (F.bid + F.G - 48) % F.G;
      pg8::gemm_phase(F.lds, d, E); }
    { EpiStore E; E.O = (bf16_t*)(F.act + A_VST); E.ldo = TT; E.lgin = 20; E.gout = 0; E.mrows = 256;
      pg8::DenseT<true, 0x7A7A7A7A, 0x7A7A7A7A> d; d.A = (const bf16_t*)(W + WO_I8 + (size_t)OFF_VS * 1024); d.Bt = (const bf16_t*)(F.ws + WS_H8); d.nM = 1; d.nN = TT / 256; d.K = 512; d.G = F.G; d.c = (F.bid + F.G - 80) % F.G;
      pg8::gemm_phase(F.lds, d, E); }
}
__device__ __forceinline__ void phase_g2(const Frame& F, int l) {
    unsigned char* W = F.wsm(l);
    LAS float* tab = (LAS float*)(F.lds + LDS_SCR);
    { EpiStoreRS<384> E; E.O = (bf16_t*)(F.act + A_Q); E.ldo = 768; E.lgin = 20; E.gout = 0; E.src = (const bf16_t*)(F.act + A_CQ); E.tab = tab;
      pg8::gemm_phase(F.lds, dense(F, F.act + A_CQ, W + WO_UQ, TT, 768, 384, 0), E); }
    { EpiStoreRS<256> E; E.O = (bf16_t*)(F.act + A_K); E.ldo = 768; E.lgin = 6; E.gout = 96; E.src = (const bf16_t*)(F.act + A_CKV); E.tab = tab;
      pg8::gemm_phase(F.lds, dense(F, F.act + A_CKV, W + WO_K, TT, 512, 256, 208), E); }
    { EpiStoreCS E; E.O = (bf16_t*)(F.act + A_VT); E.ldo = TT; E.src = (const bf16_t*)(F.act + A_CKV); E.tab = tab;
      pg8::gemm_phase(F.lds, dense(F, W + WO_V, F.act + A_CKV, 512, TT, 256, 88), E); }
}
__device__ __forceinline__ void phase_g4(const Frame& F, int l, int Mr) {
    unsigned char* W = F.wsm(l);
    pg8::Merge3HT<true, 0x79797979, 0x79797979> P;
    P.A0 = (const bf16_t*)(F.act + A_YMLA); P.A1 = (const bf16_t*)(F.act + A_POOL); P.A2 = (const bf16_t*)(F.act + A_YSWA);
    P.B0 = (const bf16_t*)(W + WO_BRM); P.B1 = (const bf16_t*)(W + WO_COMB); P.B2 = (const bf16_t*)(W + WO_BRS); P.nM = Mr / 256; P.nN = 8; P.K = 256; P.G = F.G; P.c = F.bid;
    EpiMerge3H E; E.out = (bf16_t*)(F.act + A_H); E.gates = F.act + A_GATES;
    pg8::gemm_phase(F.lds, P, E);
}
__device__ __forceinline__ void phase_g5(const Frame& F, int l, int Mr) {
    EpiResid E; E.X = (bf16_t*)(F.ws + WS_X); E.xlat = (l == 0) ? F.in(I_X) : nullptr; E.xctx = (l == 0) ? F.in(I_CTX) : nullptr; E.mod2 = F.mod(l, 0, 2);
    pg8::gemm_phase(F.lds, dense(F, F.act + A_H, F.wsm(l) + WO_OUT, Mr, 1024, 1024, 0), E);
}
__device__ __forceinline__ void phase_g6(const Frame& F, int l, int Mr) {
    EpiG6 E; E.hs = (bf16_t*)(F.act + A_HS); E.logits = (float*)(F.ws + WS_LOGIT); E.logits2 = (float*)(F.ws + WS_LOGIT2); E.mrows = Mr;
    pg8::gemm_phase(F.lds, dense(F, F.act + A_F, F.wsm(l) + WO_RS, Mr, 768, 1024, 0), E);
}
__device__ __forceinline__ void phase_g7(const Frame& F, int l, int Mr) {
    pg8::Grouped<true, true, 0x7A7A7A7A, 0x7A7A7A7A> P;
    P.A = (const bf16_t*)(F.act + A_F8); P.W = (const bf16_t*)(F.ws + WS_WGU); P.estride = (size_t)512 * 512; P.ncol0 = 0;
    const RouteTabs rt = route_tables(F, l, true); P.ntiles = rt.ntiles; P.tile_e = rt.tile_e; P.tile_base = rt.tile_base; P.tile_nv = rt.tile_nv; P.ptok = (const int*)(F.ws + WS_PTOK); P.nN = 2; P.K = 512; P.G = F.G; P.c = F.bid;
    EpiG7 E; E.hmid = F.act + A_HMID; E.pwt = (const float*)(F.ws + WS_PWT); E.tile_base = rt.tile_base; E.tile_nv = rt.tile_nv;
    pg8::gemm_phase(F.lds, P, E);
    { const int rem = (P.ntiles * 2) % F.G; int nw = F.G - rem, rank = F.bid - rem;
      if (rem == 0 || nw < 64) { nw = F.G; rank = F.bid; }
      if (rank >= 0) { EpiY8 E2; E2.Y = F.act + A_YS; E2.tile_nv = nullptr; pg8::Dense d = dense(F, F.act + A_HS, F.wsm(l) + WO_SD, Mr, 1024, 256, 0); d.G = nw; d.c = rank; pg8::gemm_phase(F.lds, d, E2); } }
}
__device__ __forceinline__ void phase_g8(const Frame& F, int l, int Mr) {
    pg8::Grouped<false, true, 0x79797979, 0x79797979> P;
    P.A = (const bf16_t*)(F.act + A_HMID); P.W = (const bf16_t*)(F.ws + WS_WDN); P.estride = (size_t)1024 * 128; P.ncol0 = 0;
    const RouteTabs rt = route_tables(F, l, true); P.ntiles = rt.ntiles; P.tile_e = rt.tile_e; P.tile_base = rt.tile_base; P.tile_nv = rt.tile_nv; P.ptok = nullptr; P.nN = 4; P.K = 128; P.G = F.G; P.c = F.bid;
    EpiY8 E; E.Y = F.act + A_YH0; E.tile_nv = rt.tile_nv;
    pg8::gemm_phase(F.lds, P, E);
}

constexpr int NPH_LAYER = 11, NPHASE = 2 + DEPTH * NPH_LAYER;
__global__ void __launch_bounds__(NTHREADS) __attribute__((amdgpu_waves_per_eu(2, 2))) fwd_kernel(Params p) {
    extern __shared__ __attribute__((aligned(16))) unsigned char lds_raw[];
    Frame F; F.lds = (LAS unsigned char*)lds_raw; F.tid = threadIdx.x; F.lane = F.tid & 63; F.wid = __builtin_amdgcn_readfirstlane(F.tid >> 6);
    F.G = gridDim.x; F.bid = blockIdx.x; F.ws = p.ws; F.act = p.ws + WS_ACT;
    volatile LAS unsigned* bw = (volatile LAS unsigned*)(F.lds + LDS_MISC);
    if (F.tid < 4) bw[F.tid] = 0u;
    if (F.tid == 0) { LAS unsigned* q = (LAS unsigned*)(F.lds + LDS_PTRS);
#pragma unroll
        for (int i = 0; i < 30; ++i) { const unsigned long long v = (i < 29) ? (unsigned long long)p.in[i < 29 ? i : 0] : (unsigned long long)p.out; q[2 * i] = (unsigned)v; q[2 * i + 1] = (unsigned)(v >> 32); } }
    __syncthreads();
    XcdBarrier bar; bar.bar = (unsigned*)(p.ws + WS_CTL) + CW_BAR; bar.x = 0; bar.st = bw;
    if (p.use_bar) bar = xcd_barrier_post((unsigned*)(p.ws + WS_CTL) + CW_BAR, bw);
    int ph = 0;
#ifndef PH_ONLY
#define PH_ONLY -1
#endif
#define RUNX(idx, body) do { if (ph >= p.ph_lo && ph < p.ph_hi) { if (PH_ONLY < 0 || PH_ONLY == (idx)) { unsigned long long wsl = (unsigned long long)p.ws; asm volatile("" : "+s"(wsl)); F.ws = (unsigned char*)(__attribute__((address_space(1))) unsigned char*)wsl; F.act = F.ws + WS_ACT; body; } if (p.use_bar && ph + 1 < p.ph_hi) xcd_barrier(bar); } ++ph; } while (0)
    RUNX(0, phase_p0(F));
    RUNX(1, phase_e1(F));
#define LAYER(l) do { \
        const bool last = (l == DEPTH - 1); \
        const int Te = last ? TL : TT; \
        const int busy = (TT / 256) * (NINP / 256) + TT / 256 - 5 * F.G;     \
        const int ng1 = (l > 0 && busy > 0 && busy < F.G) ? (F.G - busy) * CV_G1 : 0; \
        const int nb6 = (Te / 256) * 3; const int ng6 = nb6 < F.G ? (F.G - nb6) * CV_G6 : 0; \
        const int busy5 = (Te / 256) * 4 - F.G; const int ng5 = (l == 0 && busy5 > 0 && busy5 < F.G) ? CV_G5 : 0; \
        const int ngm = CT_EXP / 4 - ng5 - ng6 - ng1;        \
        RUNX(2, { phase_g1(F, l); if (l == 0) { if (busy > 0 && busy < F.G) setup_layer(F, 1, F.bid - busy, F.G - busy); else setup_layer(F, 1, F.bid, F.G); } \
            else if (ng1 > 0) conv_exp_range(F, l, ngm + ng6 + ng5, ng1, F.bid - busy, F.G - busy); }); \
          \
        RUNX(3, { const bool gfirst = ((F.bid >> 3) & 1) != 0; if (gfirst) phase_g2(F, l); phase_e3(F); if (!gfirst) phase_g2(F, l); }); \
          \
        RUNX(6, { const bool cfirst = ((F.bid >> 3) & 1) != 0; if (l > 0 && cfirst) conv_exp_range(F, l, 0, ngm, F.bid, F.G); phase_att(F, l); if (l > 0 && !cfirst) { __syncthreads(); conv_exp_range(F, l, 0, ngm, F.bid, F.G); } }); \
        RUNX(7, { phase_g4(F, l, Te); if (l == 0) { const int extra = (Te / 256) * 8 - 2 * F.G;   \
            if (extra > 0 && extra < F.G) conv_exp_range(F, 0, 0, ngm, F.bid - extra, F.G - extra); else conv_exp_range(F, 0, 0, ngm, F.bid, F.G); } }); \
        RUNX(8, { phase_g5(F, l, Te); if (ng5 > 0) conv_exp_range(F, l, ngm + ng6, ng5, F.bid - busy5, F.G - busy5); }); \
        RUNX(9, phase_e5(F, l, Te)); \
        RUNX(10, { phase_g6(F, l, Te); if (ng6 > 0) conv_exp_range(F, l, ngm, ng6, F.bid - nb6, F.G - nb6); }); \
        RUNX(11, phase_r1(F, l, Te)); \
        RUNX(13, phase_g7(F, l, Te)); \
        RUNX(14, phase_g8(F, l, Te)); \
        RUNX(15, phase_e6(F, l, Te)); \
    } while (0)
    LAYER(0);
    LAYER(1);
#undef LAYER
#undef RUNX
}

extern "C" void kernel_launch(void* const* d_in, const int* in_sizes, int n_in, void* d_out, int out_size, void* d_ws, size_t ws_size, hipStream_t stream) {
    static int grid = 0;
    if (grid == 0) {
        if (n_in != 29 || out_size != TL * DM || ws_size < WS_END) {
            fprintf(stderr, "kernel_launch: expected 29 inputs, %d outputs, >= %zu bytes of workspace; got n_in %d, out %d, ws %zu; nothing launched\n", TL * DM, (size_t)WS_END, n_in, out_size, ws_size);
            grid = -1; return; }
        int dev = 0, cus = 0, per_cu = 0;
        if (hipGetDevice(&dev) != hipSuccess || hipDeviceGetAttribute(&cus, hipDeviceAttributeMultiprocessorCount, dev) != hipSuccess) { grid = -1; return; }
        if (hipFuncSetAttribute((const void*)fwd_kernel, hipFuncAttributeMaxDynamicSharedMemorySize, LDS_BYTES) != hipSuccess) { fprintf(stderr, "kernel_launch: hipFuncSetAttribute failed\n"); grid = -1; return; }
        if (hipOccupancyMaxActiveBlocksPerMultiprocessor(&per_cu, (const void*)fwd_kernel, NTHREADS, LDS_BYTES) != hipSuccess || per_cu < 1) {
            fprintf(stderr, "kernel_launch: occupancy query reports %d workgroups per CU\n", per_cu); (void)hipGetLastError(); }
        grid = cus < 256 ? cus : 256;
        if (grid != 256) fprintf(stderr, "kernel_launch: %d CUs; this build is laid out for 256\n", cus);
    }
    if (grid < 0) return;
    if (hipMemsetAsync((char*)d_ws + WS_CTL, 0, CTL_BYTES, stream) != hipSuccess) return;
    Params p{};
    for (int i = 0; i < 29; ++i) p.in[i] = (const float*)d_in[i];
    p.out = (float*)d_out; p.ws = (unsigned char*)d_ws; p.pad = 0;
#if KL_LAUNCH_MODE == 1
    p.ph_lo = 0; p.ph_hi = NPHASE; p.use_bar = 1;
    hipLaunchKernelGGL(fwd_kernel, dim3(grid), dim3(NTHREADS), LDS_BYTES, stream, p);
#else
    p.use_bar = 0;
    for (int i = 0; i < NPHASE; ++i) { p.ph_lo = i; p.ph_hi = i + 1; hipLaunchKernelGGL(fwd_kernel, dim3(grid), dim3(NTHREADS), LDS_BYTES, stream, p); }
#endif
}
```
